# Optimizing an MI355X kernel written in HIP

```python
import math
import jax
import jax.numpy as jnp
from jax import lax
import numpy as np

D_MODEL = 2048
BATCH = 2
SEQ = 8192
DEPTH = 2

CHUNK = 64
N_META = 16
EPS = 1e-6

A_HEAD_DIM = 128
A_HEADS = D_MODEL // (2 * A_HEAD_DIM)
A_WIDTH = A_HEADS * A_HEAD_DIM
Q_BLOCK = 128

B_CHANNELS = D_MODEL // 2
B_CONV_WIDTH = 31

C_HEAD_DIM = 128
C_HEADS = D_MODEL // (2 * C_HEAD_DIM)
C_WIDTH = C_HEADS * C_HEAD_DIM
C_CONV_WIDTH = 4

D_WIDTH = D_MODEL // 2
D_BLOCK_DIM = 128
D_BLOCKS = D_WIDTH // D_BLOCK_DIM
D_CONV_WIDTH = 4
LRU_C = 8.0

N_GROUPS = 4
EXPERTS_PER_GROUP = 8
N_EXPERTS = N_GROUPS * EXPERTS_PER_GROUP
TOP_K = 2
D_EXPERT = D_MODEL // 4
MOE_BLOCK = 128

EVEN_IN_SIZES = (A_WIDTH, A_WIDTH, A_WIDTH, A_HEADS, B_CHANNELS, B_CHANNELS)
ODD_IN_SIZES = (3 * C_WIDTH, C_HEADS, C_HEADS, C_WIDTH, D_WIDTH, D_WIDTH)
EVEN_OUT = A_WIDTH + B_CHANNELS
ODD_OUT = C_WIDTH + D_WIDTH
N_EVEN = (DEPTH + 1) // 2
N_ODD = DEPTH // 2

kernel_name = "hybrid_fox_conformer_gdn_rglru_hmoe"


def _split(z, sizes):
    return jnp.split(z, [int(s) for s in np.cumsum(sizes)[:-1]], axis=-1)


def rms_norm(x, g):
    xf = x.astype(jnp.float32)
    y = xf * lax.rsqrt(jnp.mean(xf * xf, axis=-1, keepdims=True) + EPS)
    return (y * g.astype(jnp.float32)).astype(x.dtype)


def layer_norm(x, g, b):
    xf = x.astype(jnp.float32)
    mu = jnp.mean(xf, axis=-1, keepdims=True)
    var = jnp.mean(jnp.square(xf - mu), axis=-1, keepdims=True)
    y = (xf - mu) * lax.rsqrt(var + EPS)
    return (y * g.astype(jnp.float32) + b.astype(jnp.float32)).astype(x.dtype)


def l2_normalize(x):
    return x * lax.rsqrt(jnp.sum(x * x, axis=-1, keepdims=True) + EPS)


def causal_depthwise_conv(x, w):
    K, T = w.shape[0], x.shape[1]
    xp = jnp.pad(x, ((0, 0), (K - 1, 0), (0, 0)))
    y = xp[:, 0:T] * w[0]
    for j in range(1, K):
        y = y + xp[:, j:j + T] * w[j]
    return y


def forgetting_attention(q, k, v, log_f):
    Bsz, T, H, dh = q.shape
    Tp = -(-T // Q_BLOCK) * Q_BLOCK
    q, k, v = (jnp.pad(t, ((0, 0), (0, Tp - T), (0, 0), (0, 0))).transpose(0, 2, 1, 3)
               for t in (q, k, v))
    c = jnp.cumsum(jnp.pad(log_f, ((0, 0), (0, Tp - T), (0, 0))), axis=1).transpose(0, 2, 1)
    scale = dh ** -0.5
    diag = jnp.tril(jnp.ones((Q_BLOCK, Q_BLOCK), bool))
    outs = []
    for i in range(Tp // Q_BLOCK):
        q0, q1 = i * Q_BLOCK, (i + 1) * Q_BLOCK
        s = jnp.einsum('bhqd,bhkd->bhqk', q[:, :, q0:q1], k[:, :, :q1]).astype(jnp.float32) * scale
        s = s + (c[:, :, q0:q1, None] - c[:, :, None, :q1])
        mask = jnp.concatenate([jnp.ones((Q_BLOCK, q0), bool), diag], axis=1)
        p = jax.nn.softmax(jnp.where(mask, s, -jnp.inf), axis=-1)
        outs.append(jnp.einsum('bhqk,bhkd->bqhd', p.astype(v.dtype), v[:, :, :q1]))
    return jnp.concatenate(outs, axis=1)[:, :T]


def gated_delta_rule(q, k, v, g, beta):
    Bsz, T, H, dk = q.shape
    dv = v.shape[-1]
    front = (-N_META) % CHUNK
    back = (-(T + front)) % CHUNK
    Tp = T + front + back
    n = Tp // CHUNK

    def chunks(t):
        t = jnp.pad(t, ((0, 0), (front, back)) + ((0, 0),) * (t.ndim - 2))
        return jnp.moveaxis(t.reshape((Bsz, n, CHUNK, H) + t.shape[3:]), 3, 1)

    q = chunks(q) * dk ** -0.5
    k, v, g, beta = chunks(k), chunks(v), chunks(g), chunks(beta)
    gc = jnp.cumsum(g, axis=-1)
    incl = jnp.tril(jnp.ones((CHUNK, CHUNK), bool))
    strict = jnp.tril(jnp.ones((CHUNK, CHUNK), bool), -1)
    decay = jnp.exp(jnp.where(incl, gc[..., :, None] - gc[..., None, :], -jnp.inf))
    kb = k * beta[..., None]
    a_mat = jnp.where(strict, jnp.einsum('bhnid,bhnjd->bhnij', kb, k) * decay, 0.0)
    rhs = jnp.concatenate([v * beta[..., None], kb * jnp.exp(gc)[..., None]], axis=-1)
    eye = jnp.eye(CHUNK, dtype=a_mat.dtype)
    uw = lax.linalg.triangular_solve(a_mat + eye, rhs, left_side=True, lower=True,
                                     unit_diagonal=True)
    u, w = uw[..., :dv], uw[..., dv:]
    attn = jnp.einsum('bhnid,bhnjd->bhnij', q, k) * decay
    q_dec = q * jnp.exp(gc)[..., None]
    k_dec = k * jnp.exp(gc[..., -1:] - gc)[..., None]
    g_tot = jnp.exp(gc[..., -1])

    def step(S, xs):
        a_c, qd, kd, u_c, w_c, gt = xs
        v_new = u_c - jnp.einsum('bhik,bhkv->bhiv', w_c, S)
        o = jnp.einsum('bhik,bhkv->bhiv', qd, S) + jnp.einsum('bhij,bhjv->bhiv', a_c, v_new)
        S = S * gt[..., None, None] + jnp.einsum('bhik,bhiv->bhkv', kd, v_new)
        return S, o

    xs = tuple(jnp.moveaxis(t, 2, 0) for t in (attn, q_dec, k_dec, u, w, g_tot))
    S0 = jnp.zeros((Bsz, H, dk, dv), jnp.float32)
    _, o = lax.scan(step, S0, xs)
    o = jnp.transpose(o, (1, 0, 3, 2, 4)).reshape(Bsz, Tp, H, dv)
    return o[:, front:front + T]


def rg_lru(x, w_r, b_r, w_i, b_i, lam):
    Bsz, T, W = x.shape
    xb = x.reshape(Bsz, T, D_BLOCKS, D_BLOCK_DIM)
    r = jax.nn.sigmoid(jnp.einsum('btni,nio->btno', xb, w_r).reshape(Bsz, T, W) + b_r)
    i = jax.nn.sigmoid(jnp.einsum('btni,nio->btno', xb, w_i).reshape(Bsz, T, W) + b_i)
    log_a = -LRU_C * jax.nn.softplus(-lam.astype(jnp.float32)) * r.astype(jnp.float32)
    a = jnp.exp(log_a)
    b = jnp.sqrt(-jnp.expm1(2.0 * log_a)) * (i * x).astype(jnp.float32)

    def combine(left, right):
        a1, b1 = left
        a2, b2 = right
        return a1 * a2, a2 * b1 + b2

    _, h = lax.associative_scan(combine, (a, b), axis=1)
    return h.astype(x.dtype)


def even_mixer(h, w_in, forget_b, conv_w, conv_b, ln_g, ln_b, w_out):
    Bsz, T, _ = h.shape
    q, k, v, f_logit, glu_a, glu_b = _split(h @ w_in, EVEN_IN_SIZES)
    heads = lambda t: t.reshape(Bsz, T, A_HEADS, A_HEAD_DIM)
    log_f = jax.nn.log_sigmoid((f_logit + forget_b).astype(jnp.float32))
    y_a = forgetting_attention(heads(q), heads(k), heads(v), log_f).reshape(Bsz, T, A_WIDTH)
    u = glu_a * jax.nn.sigmoid(glu_b)
    u = causal_depthwise_conv(u, conv_w) + conv_b
    u = jax.nn.silu(layer_norm(u, ln_g, ln_b))
    return jnp.concatenate([y_a, u], axis=-1) @ w_out


def odd_mixer(h, w_in, qkv_conv_w, a_log, dt_bias, out_norm_g, lru_conv_w, lru_conv_b,
              w_rg, b_rg, w_ig, b_ig, lru_lambda, w_out):
    Bsz, T, _ = h.shape
    f32 = jnp.float32
    qkv, a_in, b_in, z_c, x_d, gate_d = _split(h @ w_in, ODD_IN_SIZES)
    qkv = jax.nn.silu(causal_depthwise_conv(qkv, qkv_conv_w)).astype(f32)
    q, k, v = (t.reshape(Bsz, T, C_HEADS, C_HEAD_DIM) for t in jnp.split(qkv, 3, axis=-1))
    q, k = l2_normalize(q), l2_normalize(k)
    g = -jnp.exp(a_log.astype(f32)) * jax.nn.softplus(a_in.astype(f32) + dt_bias.astype(f32))
    beta = jax.nn.sigmoid(b_in.astype(f32))
    o = gated_delta_rule(q, k, v, g, beta)
    o = rms_norm(o, out_norm_g) * jax.nn.silu(z_c.reshape(Bsz, T, C_HEADS, C_HEAD_DIM).astype(f32))
    y_c = o.reshape(Bsz, T, C_WIDTH).astype(h.dtype)
    x_r = causal_depthwise_conv(x_d, lru_conv_w) + lru_conv_b
    y_d = rg_lru(x_r, w_rg, b_rg, w_ig, b_ig, lru_lambda) * jax.nn.gelu(gate_d)
    return jnp.concatenate([y_c, y_d], axis=-1) @ w_out


def hierarchical_moe(h, w_group, b_group, w_expert, b_expert, w_gate, w_up, w_down):
    Bsz, T, D = h.shape
    xf = h.reshape(-1, D)
    N = xf.shape[0]
    g_logits = (xf @ w_group).astype(jnp.float32) + b_group
    g_sel = jnp.argmax(g_logits, axis=-1)
    g_prob = jnp.take_along_axis(jax.nn.softmax(g_logits, axis=-1), g_sel[:, None], axis=-1)
    e_logits = ((xf @ w_expert).astype(jnp.float32) + b_expert).reshape(N, N_GROUPS, EXPERTS_PER_GROUP)
    e_logits = jnp.take_along_axis(e_logits, g_sel[:, None, None], axis=1)[:, 0]
    top_p, top_i = lax.top_k(jax.nn.softmax(e_logits, axis=-1), TOP_K)
    weight = g_prob * top_p / jnp.sum(top_p, axis=-1, keepdims=True)
    expert = (g_sel[:, None] * EXPERTS_PER_GROUP + top_i).astype(jnp.int32)

    n_pairs = N * TOP_K
    e_flat = expert.reshape(-1)
    w_flat = weight.reshape(-1)
    tok = jnp.repeat(jnp.arange(N, dtype=jnp.int32), TOP_K)
    order = jnp.argsort(e_flat)
    e_sorted = e_flat[order]
    counts = jnp.bincount(e_flat, length=N_EXPERTS)
    starts = jnp.cumsum(counts) - counts
    padded = (counts + MOE_BLOCK - 1) // MOE_BLOCK * MOE_BLOCK
    p_ends = jnp.cumsum(padded)
    p_starts = p_ends - padded
    dest = p_starts[e_sorted] + jnp.arange(n_pairs) - starts[e_sorted]
    n_blocks = -(-(n_pairs + N_EXPERTS * (MOE_BLOCK - 1)) // MOE_BLOCK)
    R = n_blocks * MOE_BLOCK
    row_tok = jnp.full((R,), N, jnp.int32).at[dest].set(tok[order])
    row_w = jnp.zeros((R,), jnp.float32).at[dest].set(w_flat[order])
    block_expert = jnp.minimum(
        jnp.searchsorted(p_ends, jnp.arange(n_blocks) * MOE_BLOCK, side='right'),
        N_EXPERTS - 1).astype(jnp.int32)
    x_pad = jnp.concatenate([xf, jnp.zeros((1, D), xf.dtype)], axis=0)
    xb = x_pad[row_tok].reshape(n_blocks, MOE_BLOCK, D)

    def expert_block(args):
        x_blk, e = args
        hid = jax.nn.silu(x_blk @ w_gate[e]) * (x_blk @ w_up[e])
        return hid @ w_down[e]

    yb = lax.map(expert_block, (xb, block_expert)).reshape(R, D)
    y = jnp.zeros((N + 1, D), yb.dtype).at[row_tok].add(yb * row_w[:, None].astype(yb.dtype))
    return y[:N].reshape(Bsz, T, D)


def setup_inputs(seed: int = 0) -> dict:
    key = jax.random.key(seed)
    ks = iter(jax.random.split(key, 64))
    f32 = jnp.float32

    def nrm(shape, scale):
        return jax.random.normal(next(ks), shape, f32) * scale

    def gain(shape):
        return 1.0 + nrm(shape, 0.02)

    NE, NO = N_EVEN, N_ODD
    forget_b = jax.random.uniform(next(ks), (NE, A_HEADS), f32, 2.0, 5.0)
    a_log = jnp.log(jax.random.uniform(next(ks), (NO, C_HEADS), f32, 1.0, 16.0))
    dt = jnp.exp(jax.random.uniform(next(ks), (NO, C_HEADS), f32, math.log(1e-3), math.log(1e-1)))
    dt_bias = dt + jnp.log(-jnp.expm1(-dt))
    a0 = jax.random.uniform(next(ks), (NO, D_WIDTH), f32, 0.9, 0.999)
    s = a0 ** (1.0 / LRU_C)
    lru_lambda = jnp.log(s) - jnp.log1p(-s)
    return {
        "x": nrm((BATCH, SEQ, D_MODEL), 1.0),
        "meta_tokens": nrm((N_META, D_MODEL), 1.0),
        "norm_mix_g": gain((DEPTH, D_MODEL)),
        "norm_ffn_g": gain((DEPTH, D_MODEL)),
        "norm_final_g": gain((D_MODEL,)),
        "ab_w_in": nrm((NE, D_MODEL, sum(EVEN_IN_SIZES)), D_MODEL ** -0.5),
        "ab_forget_b": forget_b,
        "ab_conv_w": nrm((NE, B_CONV_WIDTH, B_CHANNELS), B_CONV_WIDTH ** -0.5),
        "ab_conv_b": nrm((NE, B_CHANNELS), 0.02),
        "ab_ln_g": gain((NE, B_CHANNELS)),
        "ab_ln_b": nrm((NE, B_CHANNELS), 0.02),
        "ab_w_out": nrm((NE, EVEN_OUT, D_MODEL), EVEN_OUT ** -0.5),
        "cd_w_in": nrm((NO, D_MODEL, sum(ODD_IN_SIZES)), D_MODEL ** -0.5),
        "cd_qkv_conv_w": nrm((NO, C_CONV_WIDTH, 3 * C_WIDTH), C_CONV_WIDTH ** -0.5),
        "cd_a_log": a_log,
        "cd_dt_bias": dt_bias,
        "cd_out_norm_g": gain((NO, C_HEAD_DIM)),
        "cd_lru_conv_w": nrm((NO, D_CONV_WIDTH, D_WIDTH), D_CONV_WIDTH ** -0.5),
        "cd_lru_conv_b": nrm((NO, D_WIDTH), 0.02),
        "cd_w_rg": nrm((NO, D_BLOCKS, D_BLOCK_DIM, D_BLOCK_DIM), D_BLOCK_DIM ** -0.5),
        "cd_b_rg": nrm((NO, D_WIDTH), 0.02),
        "cd_w_ig": nrm((NO, D_BLOCKS, D_BLOCK_DIM, D_BLOCK_DIM), D_BLOCK_DIM ** -0.5),
        "cd_b_ig": nrm((NO, D_WIDTH), 0.02),
        "cd_lru_lambda": lru_lambda,
        "cd_w_out": nrm((NO, ODD_OUT, D_MODEL), ODD_OUT ** -0.5),
        "moe_w_group": nrm((DEPTH, D_MODEL, N_GROUPS), D_MODEL ** -0.5),
        "moe_b_group": nrm((DEPTH, N_GROUPS), 0.01),
        "moe_w_expert": nrm((DEPTH, D_MODEL, N_EXPERTS), D_MODEL ** -0.5),
        "moe_b_expert": nrm((DEPTH, N_EXPERTS), 0.01),
        "moe_w_gate": nrm((DEPTH, N_EXPERTS, D_MODEL, D_EXPERT), D_MODEL ** -0.5),
        "moe_w_up": nrm((DEPTH, N_EXPERTS, D_MODEL, D_EXPERT), D_MODEL ** -0.5),
        "moe_w_down": nrm((DEPTH, N_EXPERTS, D_EXPERT, D_MODEL), D_EXPERT ** -0.5),
    }


def reference(x, meta_tokens, norm_mix_g, norm_ffn_g, norm_final_g,
              ab_w_in, ab_forget_b, ab_conv_w, ab_conv_b, ab_ln_g, ab_ln_b, ab_w_out,
              cd_w_in, cd_qkv_conv_w, cd_a_log, cd_dt_bias, cd_out_norm_g,
              cd_lru_conv_w, cd_lru_conv_b, cd_w_rg, cd_b_rg, cd_w_ig, cd_b_ig,
              cd_lru_lambda, cd_w_out,
              moe_w_group, moe_b_group, moe_w_expert, moe_b_expert,
              moe_w_gate, moe_w_up, moe_w_down):
    Bsz = x.shape[0]
    meta = jnp.broadcast_to(meta_tokens[None].astype(x.dtype), (Bsz, N_META, D_MODEL))
    h = jnp.concatenate([meta, x], axis=1)
    for layer in range(DEPTH):
        i = layer // 2
        hn = rms_norm(h, norm_mix_g[layer])
        if layer % 2 == 0:
            h = h + even_mixer(hn, ab_w_in[i], ab_forget_b[i], ab_conv_w[i], ab_conv_b[i],
                               ab_ln_g[i], ab_ln_b[i], ab_w_out[i])
        else:
            h = h + odd_mixer(hn, cd_w_in[i], cd_qkv_conv_w[i], cd_a_log[i], cd_dt_bias[i],
                              cd_out_norm_g[i], cd_lru_conv_w[i], cd_lru_conv_b[i],
                              cd_w_rg[i], cd_b_rg[i], cd_w_ig[i], cd_b_ig[i],
                              cd_lru_lambda[i], cd_w_out[i])
        h = h + hierarchical_moe(rms_norm(h, norm_ffn_g[layer]), moe_w_group[layer],
                                 moe_b_group[layer], moe_w_expert[layer], moe_b_expert[layer],
                                 moe_w_gate[layer], moe_w_up[layer], moe_w_down[layer])
    return rms_norm(h, norm_final_g)[:, N_META:]
```

```cpp
#include <hip/hip_runtime.h>
#include <hip/hip_cooperative_groups.h>
#include <cstdio>
#include <cstdint>
namespace cg = cooperative_groups;
#define MK_ONE_LAUNCH 1
#define MK_LAST_PHASE 99
#define MK_EXTRA_PHASE -1
#define MK_EXTRA_REPS 1
namespace pg8 {
#define PG8_LAS __attribute__((address_space(3)))
typedef unsigned short bf16_t;
typedef short bf16x8 __attribute__((ext_vector_type(8)));
typedef float f32x4 __attribute__((ext_vector_type(4)));
typedef unsigned u32x4 __attribute__((ext_vector_type(4)));
constexpr int BM = 256, BK = 64, HALF = 128, HTB = HALF * BK * 2  , STAGE_BYTES = 8 * HTB, NXCD = 8, WGM = 4;

__host__ __device__ __forceinline__ int lds_byte(int r, int c) { const int st = (r >> 4) * 2 + (c >> 5), rr = r & 15, cc = c & 31, ob = rr * 64 + cc * 2; return st * 1024 + (ob ^ (((ob >> 9) & 1) << 5)); }
__host__ __device__ __forceinline__ void stage_rc(int b, int& R, int& C) { const int st = b / 1024, sb = b % 1024, swz = sb ^ (((sb >> 9) & 1) << 5); R = (st >> 1) * 16 + swz / 64; C = (st & 1) * 32 + (swz % 64) / 2; }
__host__ __device__ __forceinline__ int perm32(int rho) { const int n = rho >> 4, i = rho & 15; return 8 * (i >> 2) + 4 * n + (i & 3); }

struct Unit { int pm, pn; };
struct Gemm { const bf16_t* A; const bf16_t* Bt; int M, N, K; };

struct StaticOrder {
    int nM, nN, nwg, G, c;
    __host__ __device__ void init(int M, int N, int G_, int c_) { nM = M / BM; nN = N / BM; nwg = nM * nN; G = G_; c = c_; }
    __host__ __device__ bool next(int i, Unit& u) const {
        const long L = (long)i * G + c; if (L >= nwg) return false;
        int wgid = (int)L; { const int q = nwg / NXCD, r = nwg % NXCD, xcd = wgid % NXCD, off = wgid / NXCD; wgid = (xcd < r ? xcd * (q + 1) : r * (q + 1) + (xcd - r) * q) + off; }
        const int nig = WGM * nN, gid = wgid / nig, fm = gid * WGM, gsz = (nM - fm) < WGM ? (nM - fm) : WGM;
        u.pm = fm + ((wgid % nig) % gsz); u.pn = (wgid % nig) / gsz; return true;
    }
    __device__ __forceinline__ void a_ready(const Unit&) const {}
    __device__ __forceinline__ void done(const Unit&) const {}
};

__device__ __forceinline__ unsigned cvt_pk_bf16(float lo, float hi) { unsigned r; asm volatile("v_cvt_pk_bf16_f32 %0, %1, %2" : "=v"(r) : "v"(lo), "v"(hi)); return r; }
typedef float f32x2 __attribute__((ext_vector_type(2)));
__device__ __forceinline__ f32x2 gelu_pk(f32x2 v) {
    const f32x2 av = __builtin_elementwise_abs(v), d = av * 0.2316418882f + 1.0f;
    f32x2 t; t.x = __builtin_amdgcn_rcpf(d.x); t.y = __builtin_amdgcn_rcpf(d.y);
    f32x2 q = t * 0.5307027145f + (-0.7265760135f); q = q * t + 0.7107068705f; q = q * t + (-0.142248368f); q = q * t + 0.127414796f; q = q * t;
    const f32x2 s = (v * v) * (-0.72134752044f);
    f32x2 e; e.x = __builtin_amdgcn_exp2f(s.x); e.y = __builtin_amdgcn_exp2f(s.y);
    const f32x2 m = v * (q * e), r = v - m;
    f32x2 o; o.x = v.x < 0.f ? m.x : r.x; o.y = v.y < 0.f ? m.y : r.y; return o;
}

template <int ACT  > struct EpiBf16 {
    static constexpr bool PERM = true, AFTER_DRAIN = false; static_assert(ACT == 0 || ACT == 1, "EpiBf16: ACT is 0 (none) or 1 (gelu_pk)");
    bf16_t* O; int ldc; const float* bias; int split_cols; size_t split_stride; float scale0;
    __device__ __forceinline__ void operator()(const f32x4 (&acc)[2][2][4][2], const Unit& u, int wr, int wc, int fr, int fq) const {
        const int row0 = u.pm * BM + wr * 64 + fr; int colt = u.pn * BM; bf16_t* base = O;
        float sc = 1.f; if (split_cols) { const int t = colt / split_cols; base += (size_t)t * split_stride; colt -= t * split_cols; if (t == 0) sc = scale0; }
        const int col0 = colt + wc * 32 + 8 * fq, bcol0 = u.pn * BM + wc * 32 + 8 * fq;
        f32x4 bv[2][2];
#pragma unroll
        for (int bj = 0; bj < 2; ++bj)
#pragma unroll
            for (int n = 0; n < 2; ++n) bv[bj][n] = bias ? *(const f32x4*)(bias + bcol0 + bj * HALF + 4 * n) : (f32x4){0.f, 0.f, 0.f, 0.f};
#pragma unroll
        for (int ai = 0; ai < 2; ++ai)
#pragma unroll
            for (int m = 0; m < 4; ++m) { bf16_t* rowp = base + (size_t)(row0 + ai * HALF + m * 16) * ldc + col0;
#pragma unroll
                for (int bj = 0; bj < 2; ++bj) { f32x4 v0 = acc[ai][bj][m][0] + bv[bj][0], v1 = acc[ai][bj][m][1] + bv[bj][1];
                    if (ACT == 1) { f32x2 a = gelu_pk((f32x2){v0[0], v0[1]}), b = gelu_pk((f32x2){v0[2], v0[3]}), c = gelu_pk((f32x2){v1[0], v1[1]}), d = gelu_pk((f32x2){v1[2], v1[3]});
                        v0 = (f32x4){a.x, a.y, b.x, b.y}; v1 = (f32x4){c.x, c.y, d.x, d.y}; }
                    v0 = v0 * sc; v1 = v1 * sc; u32x4 w; w.x = cvt_pk_bf16(v0[0], v0[1]); w.y = cvt_pk_bf16(v0[2], v0[3]); w.z = cvt_pk_bf16(v1[0], v1[1]); w.w = cvt_pk_bf16(v1[2], v1[3]);
                    *(u32x4*)(rowp + bj * HALF) = w; } }
    }
};

struct EpiResid {
    static constexpr bool PERM = true, AFTER_DRAIN = false;
    bf16_t* C; int ldc;
    __device__ __forceinline__ void operator()(const f32x4 (&acc)[2][2][4][2], const Unit& u, int wr, int wc, int fr, int fq) const {
        const int row0 = u.pm * BM + wr * 64 + fr, col0 = u.pn * BM + wc * 32 + 8 * fq;
#pragma unroll
        for (int ai = 0; ai < 2; ++ai)
#pragma unroll
            for (int m = 0; m < 4; ++m) { bf16_t* rowp = C + (size_t)(row0 + ai * HALF + m * 16) * ldc + col0;
#pragma unroll
                for (int bj = 0; bj < 2; ++bj) { const u32x4 o = *(const u32x4*)(rowp + bj * HALF); const f32x4 v0 = acc[ai][bj][m][0], v1 = acc[ai][bj][m][1];
                    u32x4 w; w.x = cvt_pk_bf16(__builtin_bit_cast(float, o.x << 16) + v0[0], __builtin_bit_cast(float, o.x & 0xffff0000u) + v0[1]);
                    w.y = cvt_pk_bf16(__builtin_bit_cast(float, o.y << 16) + v0[2], __builtin_bit_cast(float, o.y & 0xffff0000u) + v0[3]);
                    w.z = cvt_pk_bf16(__builtin_bit_cast(float, o.z << 16) + v1[0], __builtin_bit_cast(float, o.z & 0xffff0000u) + v1[1]);
                    w.w = cvt_pk_bf16(__builtin_bit_cast(float, o.w << 16) + v1[2], __builtin_bit_cast(float, o.w & 0xffff0000u) + v1[3]);
                    *(u32x4*)(rowp + bj * HALF) = w; } }
    }
};
struct EpiIn0 {
    static constexpr bool PERM = true, AFTER_DRAIN = false;
    bf16_t* Z; bf16_t* U;
    __device__ __forceinline__ void operator()(const f32x4 (&acc)[2][2][4][2], const Unit& u, int wr, int wc, int fr, int fq) const {
        const int row0 = u.pm * BM + wr * 64 + fr;
        if (u.pn < 12) {
            const int col0 = u.pn * BM + wc * 32 + 8 * fq;
#pragma unroll
            for (int ai = 0; ai < 2; ++ai)
#pragma unroll
                for (int m = 0; m < 4; ++m) { bf16_t* rowp = Z + (size_t)(row0 + ai * HALF + m * 16) * 3072 + col0;
#pragma unroll
                    for (int bj = 0; bj < 2; ++bj) { const f32x4 v0 = acc[ai][bj][m][0], v1 = acc[ai][bj][m][1];
                        u32x4 w; w.x = cvt_pk_bf16(v0[0], v0[1]); w.y = cvt_pk_bf16(v0[2], v0[3]); w.z = cvt_pk_bf16(v1[0], v1[1]); w.w = cvt_pk_bf16(v1[2], v1[3]);
                        *(u32x4*)(rowp + bj * HALF) = w; } }
        } else {
            const int col0 = (u.pn - 12) * HALF + wc * 32 + 8 * fq;
#pragma unroll
            for (int ai = 0; ai < 2; ++ai)
#pragma unroll
                for (int m = 0; m < 4; ++m) { bf16_t* rowp = U + (size_t)(row0 + ai * HALF + m * 16) * 1024 + col0;
                    float h[8];
#pragma unroll
                    for (int n = 0; n < 2; ++n)
#pragma unroll
                        for (int j = 0; j < 4; ++j) { const float a = acc[ai][0][m][n][j], b = acc[ai][1][m][n][j]; h[4 * n + j] = a * __builtin_amdgcn_rcpf(1.0f + __expf(-b)); }
                    u32x4 w; w.x = cvt_pk_bf16(h[0], h[1]); w.y = cvt_pk_bf16(h[2], h[3]); w.z = cvt_pk_bf16(h[4], h[5]); w.w = cvt_pk_bf16(h[6], h[7]);
                    *(u32x4*)rowp = w; }
        }
    }
};
struct EpiSwiGLU {
    static constexpr bool PERM = true, AFTER_DRAIN = false;
    bf16_t* O;
    __device__ __forceinline__ void operator()(const f32x4 (&acc)[2][2][4][2], const Unit& u, int wr, int wc, int fr, int fq) const {
        const int row0 = u.pm * BM + wr * 64 + fr, col0 = (u.pn & 3) * HALF + wc * 32 + 8 * fq;
#pragma unroll
        for (int ai = 0; ai < 2; ++ai)
#pragma unroll
            for (int m = 0; m < 4; ++m) { bf16_t* rowp = O + (size_t)(row0 + ai * HALF + m * 16) * 512 + col0;
                float h[8];
#pragma unroll
                for (int n = 0; n < 2; ++n)
#pragma unroll
                    for (int j = 0; j < 4; ++j) { const float g = acc[ai][0][m][n][j], up = acc[ai][1][m][n][j]; h[4 * n + j] = g * __builtin_amdgcn_rcpf(1.0f + __expf(-g)) * up; }
                u32x4 w; w.x = cvt_pk_bf16(h[0], h[1]); w.y = cvt_pk_bf16(h[2], h[3]); w.z = cvt_pk_bf16(h[4], h[5]); w.w = cvt_pk_bf16(h[6], h[7]);
                *(u32x4*)rowp = w; }
    }
};
struct EpiDown {
    static constexpr bool PERM = true, AFTER_DRAIN = false;
    bf16_t* O;
    __device__ __forceinline__ void operator()(const f32x4 (&acc)[2][2][4][2], const Unit& u, int wr, int wc, int fr, int fq) const {
        const int row0 = u.pm * BM + wr * 64 + fr, col0 = (u.pn & 7) * BM + wc * 32 + 8 * fq;
#pragma unroll
        for (int ai = 0; ai < 2; ++ai)
#pragma unroll
            for (int m = 0; m < 4; ++m) { bf16_t* rowp = O + (size_t)(row0 + ai * HALF + m * 16) * 2048 + col0;
#pragma unroll
                for (int bj = 0; bj < 2; ++bj) { const f32x4 v0 = acc[ai][bj][m][0], v1 = acc[ai][bj][m][1];
                    u32x4 w; w.x = cvt_pk_bf16(v0[0], v0[1]); w.y = cvt_pk_bf16(v0[2], v0[3]); w.z = cvt_pk_bf16(v1[0], v1[1]); w.w = cvt_pk_bf16(v1[2], v1[3]);
                    *(u32x4*)(rowp + bj * HALF) = w; } }
    }
};
struct Order64 : StaticOrder {
    __device__ __forceinline__ bool next(int i, Unit& u) const { if (!StaticOrder::next(i, u)) return false; u.pm += (u.pm >= 32); return true; }
};
struct MoeOrder {
    int NB, ncol, nwg, G, c; const PG8_LAS int* blk_e;
    __device__ __forceinline__ bool next(int i, Unit& u) const {
        const long L = (long)i * G + c; if (L >= nwg) return false;
        int wgid = (int)L; { const int q = nwg / NXCD, r = nwg % NXCD, xcd = wgid % NXCD, off = wgid / NXCD; wgid = (xcd < r ? xcd * (q + 1) : r * (q + 1) + (xcd - r) * q) + off; }
        const int rb = wgid / ncol, pnl = wgid - rb * ncol;
        u.pm = rb; u.pn = blk_e[rb] * ncol + pnl; return true;
    }
    __device__ __forceinline__ void a_ready(const Unit&) const {}
    __device__ __forceinline__ void done(const Unit&) const {}
};
template <class Epi, class Sched, bool ALIGN_EPI = false, bool SP2 = false>
__device__ __forceinline__ void gemm_phase(PG8_LAS unsigned char* lds, const Gemm g, const Sched& S, const Epi& E) {
    const int tid = threadIdx.x, wid = __builtin_amdgcn_readfirstlane(tid >> 6), lane = tid & 63, wr = wid >> 2, wc = wid & 3, fr = lane & 15, fq = lane >> 4;
    const int K = g.K, nt = K / BK;
    unsigned voffA[2], voffB[2];
#pragma unroll
    for (int i = 0; i < 2; ++i) { int R, C; stage_rc(tid * 16 + i * 8192, R, C); const int Rb = Epi::PERM ? ((R & ~31) + perm32(R & 31)) : R;
        voffA[i] = (unsigned)(R * K + C) * 2u; voffB[i] = (unsigned)(Rb * K + C) * 2u; }
    const size_t kstep = (size_t)(BK * 2);
    const size_t hstep = (size_t)HALF * K * 2;
    const size_t tstep = 2 * hstep;
    const unsigned ldsw = (unsigned)wid * 1024u;
    const int aoff = lds_byte(wr * 64 + fr, fq * 8), boff = lds_byte(wc * 32 + fr, fq * 8);
#define PG8_SA(b, h) (((b) * 2 + (h)) * HTB)
#define PG8_SB(b, h) ((4 + (b) * 2 + (h)) * HTB)
#define PG8_STAGE(bufoff, gbase, voff) do { _Pragma("unroll") for (int _i = 0; _i < 2; ++_i) \
        __builtin_amdgcn_global_load_lds((const unsigned*)((const char*)(gbase) + (voff)[_i]), (PG8_LAS unsigned*)(lds + (bufoff) + ldsw + _i * 8192), 16, 0, 0); } while (0)
#define PG8_LDA(dst, b, h) do { _Pragma("unroll") for (int m = 0; m < 4; ++m) _Pragma("unroll") for (int k = 0; k < 2; ++k) dst[m][k] = *(const PG8_LAS bf16x8*)(lds + PG8_SA(b, h) + aoff + m * 2048 + k * 1024); } while (0)
#define PG8_LDB(dst, b, h) do { _Pragma("unroll") for (int n = 0; n < 2; ++n) _Pragma("unroll") for (int k = 0; k < 2; ++k) dst[n][k] = *(const PG8_LAS bf16x8*)(lds + PG8_SB(b, h) + boff + n * 2048 + k * 1024); } while (0)
#define PG8_MMA(ai, bj, At, Bt) do { __builtin_amdgcn_s_setprio(1); _Pragma("unroll") for (int m = 0; m < 4; ++m) _Pragma("unroll") for (int n = 0; n < 2; ++n) _Pragma("unroll") for (int k = 0; k < 2; ++k) \
        acc[ai][bj][m][n] = __builtin_amdgcn_mfma_f32_16x16x32_bf16(Bt[n][k], At[m][k], acc[ai][bj][m][n], 0, 0, 0); __builtin_amdgcn_s_setprio(0); } while (0)
#define PG8_WAIT_V(n) asm volatile("s_waitcnt vmcnt(" #n ")" ::: "memory")
#define PG8_WAIT_L(n) asm volatile("s_waitcnt lgkmcnt(" #n ")" ::: "memory")
#define PG8_BAR __builtin_amdgcn_s_barrier()
#define PG8_SCHED __builtin_amdgcn_sched_barrier(0)
    Unit cur, nxt; int ui = 0;
    if (!S.next(0, cur)) return;
    f32x4 acc[2][2][4][2];
#pragma unroll
    for (int a = 0; a < 2; ++a)
#pragma unroll
        for (int b = 0; b < 2; ++b)
#pragma unroll
            for (int m = 0; m < 4; ++m)
#pragma unroll
                for (int n = 0; n < 2; ++n) acc[a][b][m][n] = (f32x4){0.f, 0.f, 0.f, 0.f};
    bf16x8 At[4][2], B0[2][2], B1[2][2];
    const char* cA = (const char*)g.A + (size_t)cur.pm * tstep; const char* cB = (const char*)g.Bt + (size_t)cur.pn * tstep;
    S.a_ready(cur);
    if constexpr (SP2) {
        PG8_STAGE(PG8_SB(0, 0), cB, voffB); PG8_STAGE(PG8_SB(0, 1), cB + hstep, voffB); PG8_STAGE(PG8_SA(0, 0), cA, voffA); PG8_STAGE(PG8_SA(0, 1), cA + hstep, voffA);
        if (wr == 1) PG8_BAR;
        PG8_WAIT_V(2); PG8_BAR;
        PG8_STAGE(PG8_SB(1, 0), cB + kstep, voffB); PG8_STAGE(PG8_SA(1, 0), cA + kstep, voffA); PG8_STAGE(PG8_SB(1, 1), cB + hstep + kstep, voffB);
        PG8_WAIT_V(6); PG8_BAR;
    } else {
        PG8_STAGE(PG8_SB(0, 0), cB, voffB); PG8_STAGE(PG8_SA(0, 0), cA, voffA); PG8_STAGE(PG8_SB(0, 1), cB + hstep, voffB); PG8_STAGE(PG8_SA(0, 1), cA + hstep, voffA);
        if (wr == 1) PG8_BAR;
        PG8_WAIT_V(4); PG8_BAR;
        PG8_STAGE(PG8_SB(1, 0), cB + kstep, voffB); PG8_STAGE(PG8_SA(1, 0), cA + kstep, voffA); PG8_STAGE(PG8_SB(1, 1), cB + hstep + kstep, voffB);
        PG8_WAIT_V(6); PG8_BAR;
    }
    for (;;) {
        const bool has_next = S.next(ui + 1, nxt);
        const char* nA = has_next ? (const char*)g.A + (size_t)nxt.pm * tstep : cA; const char* nB = has_next ? (const char*)g.Bt + (size_t)nxt.pn * tstep : cB;
        for (int t = 0; t < nt; t += 2) {
            const bool last = (t == nt - 2);
            const char* a1 = cA + (size_t)(t + 1) * kstep;
            const char* a2 = last ? nA : cA + (size_t)(t + 2) * kstep; const char* b2 = last ? nB : cB + (size_t)(t + 2) * kstep;
            const char* a3 = a2 + kstep; const char* b3 = b2 + kstep;
            if (last && has_next) S.a_ready(nxt);
            if constexpr (SP2) {
            PG8_LDB(B0, 0, 0); PG8_LDB(B1, 0, 1); PG8_SCHED; PG8_LDA(At, 0, 0); PG8_STAGE(PG8_SA(1, 1), a1 + hstep, voffA);
            PG8_WAIT_V(8); PG8_WAIT_L(0); PG8_BAR; PG8_MMA(0, 0, At, B0); PG8_MMA(0, 1, At, B1); PG8_BAR; PG8_SCHED;
            PG8_LDA(At, 0, 1); PG8_STAGE(PG8_SB(0, 0), b2, voffB); PG8_STAGE(PG8_SB(0, 1), b2 + hstep, voffB); PG8_STAGE(PG8_SA(0, 0), a2, voffA);
            PG8_WAIT_V(8); PG8_WAIT_L(0); PG8_BAR; PG8_MMA(1, 0, At, B0); PG8_MMA(1, 1, At, B1); PG8_BAR; PG8_SCHED;
            PG8_LDB(B0, 1, 0); PG8_LDB(B1, 1, 1); PG8_SCHED; PG8_LDA(At, 1, 0); PG8_STAGE(PG8_SA(0, 1), a2 + hstep, voffA);
            PG8_WAIT_V(8); PG8_WAIT_L(0); PG8_BAR; PG8_MMA(0, 0, At, B0); PG8_MMA(0, 1, At, B1); PG8_BAR; PG8_SCHED;
            PG8_LDA(At, 1, 1); PG8_STAGE(PG8_SB(1, 0), b3, voffB); PG8_STAGE(PG8_SB(1, 1), b3 + hstep, voffB); PG8_STAGE(PG8_SA(1, 0), a3, voffA);
            PG8_WAIT_V(8); PG8_WAIT_L(0); PG8_BAR; PG8_MMA(1, 0, At, B0); PG8_MMA(1, 1, At, B1); PG8_BAR; PG8_SCHED;
            } else {
            PG8_LDB(B0, 0, 0); PG8_SCHED; PG8_LDA(At, 0, 0); PG8_STAGE(PG8_SA(1, 1), a1 + hstep, voffA);
            PG8_WAIT_L(8); PG8_BAR; PG8_WAIT_L(0); PG8_MMA(0, 0, At, B0); PG8_BAR; PG8_SCHED;
            PG8_LDB(B1, 0, 1); PG8_STAGE(PG8_SB(0, 0), b2, voffB);
            PG8_BAR; PG8_WAIT_L(0); PG8_MMA(0, 1, At, B1); PG8_BAR;
            PG8_LDA(At, 0, 1); PG8_STAGE(PG8_SA(0, 0), a2, voffA);
            PG8_BAR; PG8_WAIT_L(0); PG8_MMA(1, 0, At, B0); PG8_BAR; PG8_SCHED;
            PG8_STAGE(PG8_SB(0, 1), b2 + hstep, voffB);
            PG8_WAIT_V(6); PG8_BAR; PG8_MMA(1, 1, At, B1); PG8_BAR;
            PG8_LDB(B0, 1, 0); PG8_SCHED; PG8_LDA(At, 1, 0); PG8_STAGE(PG8_SA(0, 1), a2 + hstep, voffA);
            PG8_WAIT_L(8); PG8_BAR; PG8_WAIT_L(0); PG8_MMA(0, 0, At, B0); PG8_BAR; PG8_SCHED;
            PG8_LDB(B1, 1, 1); PG8_STAGE(PG8_SB(1, 0), b3, voffB);
            PG8_BAR; PG8_WAIT_L(0); PG8_MMA(0, 1, At, B1); PG8_BAR;
            PG8_LDA(At, 1, 1); PG8_STAGE(PG8_SA(1, 0), a3, voffA);
            PG8_BAR; PG8_WAIT_L(0); PG8_MMA(1, 0, At, B0); PG8_BAR; PG8_SCHED;
            PG8_STAGE(PG8_SB(1, 1), b3 + hstep, voffB);
            PG8_WAIT_V(6); PG8_BAR; PG8_MMA(1, 1, At, B1); PG8_BAR;
            }
        }
        if constexpr (ALIGN_EPI) { if (wr == 0) PG8_BAR; }
        if constexpr (!Epi::AFTER_DRAIN) { E(acc, cur, wr, wc, fr, fq); S.done(cur); }
        if (!has_next) break;
#pragma unroll
        for (int a = 0; a < 2; ++a)
#pragma unroll
            for (int b = 0; b < 2; ++b)
#pragma unroll
                for (int m = 0; m < 4; ++m)
#pragma unroll
                    for (int n = 0; n < 2; ++n) acc[a][b][m][n] = (f32x4){0.f, 0.f, 0.f, 0.f};
        cur = nxt; cA = nA; cB = nB; ++ui;
        if constexpr (ALIGN_EPI) { if (wr == 1) PG8_BAR; }
    }
    PG8_WAIT_V(0);
    if constexpr (!ALIGN_EPI) { if (wr == 0) PG8_BAR; }
    PG8_BAR;
    if constexpr (Epi::AFTER_DRAIN) { E.fused(acc, cur, wr, wc, fr, fq, lds, wid, lane); S.done(cur); }
#undef PG8_SA
#undef PG8_SB
#undef PG8_STAGE
#undef PG8_LDA
#undef PG8_LDB
#undef PG8_MMA
#undef PG8_WAIT_V
#undef PG8_WAIT_L
#undef PG8_BAR
#undef PG8_SCHED
}
template <class Epi, class Sched>
__device__ __forceinline__ void gemm_phase_gather(PG8_LAS unsigned char* lds, const Gemm g, const Sched& S, const Epi& E, const int* rowtok) {
    constexpr bool ALIGN_EPI = true, SP2 = true;
    const int tid = threadIdx.x, wid = __builtin_amdgcn_readfirstlane(tid >> 6), lane = tid & 63, wr = wid >> 2, wc = wid & 3, fr = lane & 15, fq = lane >> 4;
    const int K = g.K, nt = K / BK;
    unsigned voffA[2], voffB[2]; int rA[2];
#pragma unroll
    for (int i = 0; i < 2; ++i) { int R, C; stage_rc(tid * 16 + i * 8192, R, C); const int Rb = Epi::PERM ? ((R & ~31) + perm32(R & 31)) : R;
        voffA[i] = (unsigned)C * 2u; voffB[i] = (unsigned)(Rb * K + C) * 2u; rA[i] = R; }
    const size_t kstep = (size_t)(BK * 2);
    const size_t hstep = (size_t)HALF * K * 2;
    const size_t tstep = 2 * hstep;
    const unsigned ldsw = (unsigned)wid * 1024u;
    const int aoff = lds_byte(wr * 64 + fr, fq * 8), boff = lds_byte(wc * 32 + fr, fq * 8);
#define PG8_SA(b, h) (((b) * 2 + (h)) * HTB)
#define PG8_SB(b, h) ((4 + (b) * 2 + (h)) * HTB)
#define PG8_STAGE(bufoff, gbase, voff) do { _Pragma("unroll") for (int _i = 0; _i < 2; ++_i) \
        __builtin_amdgcn_global_load_lds((const unsigned*)((const char*)(gbase) + (voff)[_i]), (PG8_LAS unsigned*)(lds + (bufoff) + ldsw + _i * 8192), 16, 0, 0); } while (0)
#define PG8_LDA(dst, b, h) do { _Pragma("unroll") for (int m = 0; m < 4; ++m) _Pragma("unroll") for (int k = 0; k < 2; ++k) dst[m][k] = *(const PG8_LAS bf16x8*)(lds + PG8_SA(b, h) + aoff + m * 2048 + k * 1024); } while (0)
#define PG8_LDB(dst, b, h) do { _Pragma("unroll") for (int n = 0; n < 2; ++n) _Pragma("unroll") for (int k = 0; k < 2; ++k) dst[n][k] = *(const PG8_LAS bf16x8*)(lds + PG8_SB(b, h) + boff + n * 2048 + k * 1024); } while (0)
#define PG8_MMA(ai, bj, At, Bt) do { __builtin_amdgcn_s_setprio(1); _Pragma("unroll") for (int m = 0; m < 4; ++m) _Pragma("unroll") for (int n = 0; n < 2; ++n) _Pragma("unroll") for (int k = 0; k < 2; ++k) \
        acc[ai][bj][m][n] = __builtin_amdgcn_mfma_f32_16x16x32_bf16(Bt[n][k], At[m][k], acc[ai][bj][m][n], 0, 0, 0); __builtin_amdgcn_s_setprio(0); } while (0)
#define PG8_WAIT_V(n) asm volatile("s_waitcnt vmcnt(" #n ")" ::: "memory")
#define PG8_WAIT_L(n) asm volatile("s_waitcnt lgkmcnt(" #n ")" ::: "memory")
#define PG8_BAR __builtin_amdgcn_s_barrier()
#define PG8_SCHED __builtin_amdgcn_sched_barrier(0)
    Unit cur, nxt; int ui = 0;
    if (!S.next(0, cur)) return;
    f32x4 acc[2][2][4][2];
#pragma unroll
    for (int a = 0; a < 2; ++a)
#pragma unroll
        for (int b = 0; b < 2; ++b)
#pragma unroll
            for (int m = 0; m < 4; ++m)
#pragma unroll
                for (int n = 0; n < 2; ++n) acc[a][b][m][n] = (f32x4){0.f, 0.f, 0.f, 0.f};
    bf16x8 At[4][2], B0[2][2], B1[2][2];
    const char* cA = (const char*)g.A; const char* cB = (const char*)g.Bt + (size_t)cur.pn * tstep;
    unsigned gC0[2], gC1[2], gN0[2], gN1[2];
#pragma unroll
    for (int i = 0; i < 2; ++i) { gC0[i] = (unsigned)rowtok[cur.pm * BM + rA[i]] * (unsigned)(K * 2) + voffA[i]; gC1[i] = (unsigned)rowtok[cur.pm * BM + HALF + rA[i]] * (unsigned)(K * 2) + voffA[i]; }
    S.a_ready(cur);
    if constexpr (SP2) {
        PG8_STAGE(PG8_SB(0, 0), cB, voffB); PG8_STAGE(PG8_SB(0, 1), cB + hstep, voffB); PG8_STAGE(PG8_SA(0, 0), cA, gC0); PG8_STAGE(PG8_SA(0, 1), cA, gC1);
        if (wr == 1) PG8_BAR;
        PG8_WAIT_V(2); PG8_BAR;
        PG8_STAGE(PG8_SB(1, 0), cB + kstep, voffB); PG8_STAGE(PG8_SA(1, 0), cA + kstep, gC0); PG8_STAGE(PG8_SB(1, 1), cB + hstep + kstep, voffB);
        PG8_WAIT_V(6); PG8_BAR;
    } else {
        PG8_STAGE(PG8_SB(0, 0), cB, voffB); PG8_STAGE(PG8_SA(0, 0), cA, voffA); PG8_STAGE(PG8_SB(0, 1), cB + hstep, voffB); PG8_STAGE(PG8_SA(0, 1), cA + hstep, voffA);
        if (wr == 1) PG8_BAR;
        PG8_WAIT_V(4); PG8_BAR;
        PG8_STAGE(PG8_SB(1, 0), cB + kstep, voffB); PG8_STAGE(PG8_SA(1, 0), cA + kstep, voffA); PG8_STAGE(PG8_SB(1, 1), cB + hstep + kstep, voffB);
        PG8_WAIT_V(6); PG8_BAR;
    }
    for (;;) {
        const bool has_next = S.next(ui + 1, nxt);
        const char* nB = has_next ? (const char*)g.Bt + (size_t)nxt.pn * tstep : cB;
#pragma unroll
        for (int i = 0; i < 2; ++i) { gN0[i] = has_next ? (unsigned)rowtok[nxt.pm * BM + rA[i]] * (unsigned)(K * 2) + voffA[i] : gC0[i]; gN1[i] = has_next ? (unsigned)rowtok[nxt.pm * BM + HALF + rA[i]] * (unsigned)(K * 2) + voffA[i] : gC1[i]; }
        for (int t = 0; t < nt; t += 2) {
            const bool last = (t == nt - 2);
            const char* a1 = cA + (size_t)(t + 1) * kstep;
            const char* a2 = last ? cA : cA + (size_t)(t + 2) * kstep; const char* b2 = last ? nB : cB + (size_t)(t + 2) * kstep;
            unsigned g20[2], g21[2];
#pragma unroll
            for (int i = 0; i < 2; ++i) { g20[i] = last ? gN0[i] : gC0[i]; g21[i] = last ? gN1[i] : gC1[i]; }
            const char* a3 = a2 + kstep; const char* b3 = b2 + kstep;
            if (last && has_next) S.a_ready(nxt);
            if constexpr (SP2) {
            PG8_LDB(B0, 0, 0); PG8_LDB(B1, 0, 1); PG8_SCHED; PG8_LDA(At, 0, 0); PG8_STAGE(PG8_SA(1, 1), a1, gC1);
            PG8_WAIT_V(8); PG8_WAIT_L(0); PG8_BAR; PG8_MMA(0, 0, At, B0); PG8_MMA(0, 1, At, B1); PG8_BAR; PG8_SCHED;
            PG8_LDA(At, 0, 1); PG8_STAGE(PG8_SB(0, 0), b2, voffB); PG8_STAGE(PG8_SB(0, 1), b2 + hstep, voffB); PG8_STAGE(PG8_SA(0, 0), a2, g20);
            PG8_WAIT_V(8); PG8_WAIT_L(0); PG8_BAR; PG8_MMA(1, 0, At, B0); PG8_MMA(1, 1, At, B1); PG8_BAR; PG8_SCHED;
            PG8_LDB(B0, 1, 0); PG8_LDB(B1, 1, 1); PG8_SCHED; PG8_LDA(At, 1, 0); PG8_STAGE(PG8_SA(0, 1), a2, g21);
            PG8_WAIT_V(8); PG8_WAIT_L(0); PG8_BAR; PG8_MMA(0, 0, At, B0); PG8_MMA(0, 1, At, B1); PG8_BAR; PG8_SCHED;
            PG8_LDA(At, 1, 1); PG8_STAGE(PG8_SB(1, 0), b3, voffB); PG8_STAGE(PG8_SB(1, 1), b3 + hstep, voffB); PG8_STAGE(PG8_SA(1, 0), a3, g20);
            PG8_WAIT_V(8); PG8_WAIT_L(0); PG8_BAR; PG8_MMA(1, 0, At, B0); PG8_MMA(1, 1, At, B1); PG8_BAR; PG8_SCHED;
            } else {
            PG8_LDB(B0, 0, 0); PG8_SCHED; PG8_LDA(At, 0, 0); PG8_STAGE(PG8_SA(1, 1), a1 + hstep, voffA);
            PG8_WAIT_L(8); PG8_BAR; PG8_WAIT_L(0); PG8_MMA(0, 0, At, B0); PG8_BAR; PG8_SCHED;
            PG8_LDB(B1, 0, 1); PG8_STAGE(PG8_SB(0, 0), b2, voffB);
            PG8_BAR; PG8_WAIT_L(0); PG8_MMA(0, 1, At, B1); PG8_BAR;
            PG8_LDA(At, 0, 1); PG8_STAGE(PG8_SA(0, 0), a2, voffA);
            PG8_BAR; PG8_WAIT_L(0); PG8_MMA(1, 0, At, B0); PG8_BAR; PG8_SCHED;
            PG8_STAGE(PG8_SB(0, 1), b2 + hstep, voffB);
            PG8_WAIT_V(6); PG8_BAR; PG8_MMA(1, 1, At, B1); PG8_BAR;
            PG8_LDB(B0, 1, 0); PG8_SCHED; PG8_LDA(At, 1, 0); PG8_STAGE(PG8_SA(0, 1), a2 + hstep, voffA);
            PG8_WAIT_L(8); PG8_BAR; PG8_WAIT_L(0); PG8_MMA(0, 0, At, B0); PG8_BAR; PG8_SCHED;
            PG8_LDB(B1, 1, 1); PG8_STAGE(PG8_SB(1, 0), b3, voffB);
            PG8_BAR; PG8_WAIT_L(0); PG8_MMA(0, 1, At, B1); PG8_BAR;
            PG8_LDA(At, 1, 1); PG8_STAGE(PG8_SA(1, 0), a3, voffA);
            PG8_BAR; PG8_WAIT_L(0); PG8_MMA(1, 0, At, B0); PG8_BAR; PG8_SCHED;
            PG8_STAGE(PG8_SB(1, 1), b3 + hstep, voffB);
            PG8_WAIT_V(6); PG8_BAR; PG8_MMA(1, 1, At, B1); PG8_BAR;
            }
        }
        if constexpr (ALIGN_EPI) { if (wr == 0) PG8_BAR; }
        if constexpr (!Epi::AFTER_DRAIN) { E(acc, cur, wr, wc, fr, fq); S.done(cur); }
        if (!has_next) break;
#pragma unroll
        for (int a = 0; a < 2; ++a)
#pragma unroll
            for (int b = 0; b < 2; ++b)
#pragma unroll
                for (int m = 0; m < 4; ++m)
#pragma unroll
                    for (int n = 0; n < 2; ++n) acc[a][b][m][n] = (f32x4){0.f, 0.f, 0.f, 0.f};
        cur = nxt; cB = nB; ++ui;
#pragma unroll
        for (int i = 0; i < 2; ++i) { gC0[i] = gN0[i]; gC1[i] = gN1[i]; }
        if constexpr (ALIGN_EPI) { if (wr == 1) PG8_BAR; }
    }
    PG8_WAIT_V(0);
    if constexpr (!ALIGN_EPI) { if (wr == 0) PG8_BAR; }
    PG8_BAR;
    if constexpr (Epi::AFTER_DRAIN) { E.fused(acc, cur, wr, wc, fr, fq, lds, wid, lane); S.done(cur); }
#undef PG8_SA
#undef PG8_SB
#undef PG8_STAGE
#undef PG8_LDA
#undef PG8_LDB
#undef PG8_MMA
#undef PG8_WAIT_V
#undef PG8_WAIT_L
#undef PG8_BAR
#undef PG8_SCHED
}
}

namespace att {
constexpr int D = 128; constexpr float THR = 8.f; constexpr bool WSKIP = false;
constexpr float SCALE = 0.08838834764831845f;
constexpr float RSCALE = 11.313708498984761f;
constexpr int LDQ = 3072, LDO = 2048;
constexpr int NW = 8, QBLK = 32, KVBLK = 64, QB = NW * QBLK;
constexpr int SHM_V = KVBLK * D * 2, SHM_K = KVBLK * D * 2;
constexpr int WS_OFF = 2 * SHM_V + 2 * SHM_K, WS_W = 768;
constexpr int LDS_BYTES = WS_OFF + NW * WS_W;

typedef unsigned short bf16;
typedef short bf16x8 __attribute__((ext_vector_type(8)));
typedef short s16x4 __attribute__((ext_vector_type(4)));
typedef float f32x16 __attribute__((ext_vector_type(16)));
typedef float f32x4 __attribute__((ext_vector_type(4)));
typedef unsigned u32x4 __attribute__((ext_vector_type(4)));
template <class A, class Bt> struct same_t { static constexpr bool v = false; };
template <class A> struct same_t<A, A> { static constexpr bool v = true; };

#define KSWZ(row, colB) ((row) * 256 + ((colB) ^ (((row) & 7) << 4)))
#define SBAR() __builtin_amdgcn_sched_barrier(0)
__device__ __forceinline__ int v_st(int k, int c) { const int kk = (k & ~0xC) | ((k & 4) << 1) | ((k & 8) >> 1); return ((kk >> 3) * 4 + (c >> 5)) * 512 + ((kk & 7) * 32 + (c & 31)) * 2; }
__device__ __forceinline__ int v_rd_base(int lane) { return ((lane & 3) << 3) | (((lane >> 2) & 3) << 6) | (((lane >> 4) & 1) << 5) | (((lane >> 5) & 1) << 8); }
constexpr int v_rd_off(int d0, int ks, int half) { return d0 * 512 + ks * 4096 + half * 2048; }
__device__ __forceinline__ int crow(int r, int hi) { return (r & 3) + 8 * (r >> 2) + 4 * hi; }
__device__ __forceinline__ unsigned cvtpk(float lo, float hi) {
    unsigned r; asm volatile("v_cvt_pk_bf16_f32 %0, %1, %2" : "=v"(r) : "v"(lo), "v"(hi)); return r;
}
__device__ __forceinline__ bf16x8 pack8(f32x4 a, f32x4 b) {
    u32x4 w = {cvtpk(a[0], a[1]), cvtpk(a[2], a[3]), cvtpk(b[0], b[1]), cvtpk(b[2], b[3])};
    return *reinterpret_cast<bf16x8*>(&w);
}
template <class T> __device__ __forceinline__ bf16x8 load8(const T* p) {
    if constexpr (same_t<T, float>::v) { return pack8(*(const f32x4*)p, *(const f32x4*)(p + 4)); }
    else { return *reinterpret_cast<const bf16x8*>(p); }
}
__device__ __forceinline__ void mask_tile(f32x16& p0, f32x16& p1, int dq, unsigned W) {
    const float NEG = -__builtin_inff();
#pragma unroll
    for (int r = 0; r < 16; ++r) {
        const int c = (r & 3) + 8 * (r >> 2);
        if ((unsigned)(dq - c) >= W) p0[r] = NEG;
        if ((unsigned)(dq - c - 32) >= W) p1[r] = NEG;
    }
}
__device__ __forceinline__ void partialSM(f32x16& p0, f32x16& p1, float& m_reg, float& mn, float& alpha) {
    float pmax = p0[0]; for (int r = 1; r < 16; ++r) pmax = fmaxf(pmax, p0[r]); for (int r = 0; r < 16; ++r) pmax = fmaxf(pmax, p1[r]);
    { auto rr = __builtin_amdgcn_permlane32_swap(__float_as_uint(pmax), __float_as_uint(pmax), false, false);
      pmax = fmaxf(__uint_as_float(rr[0]), __uint_as_float(rr[1])); }
    constexpr float C2 = 1.4426950408889634f * SCALE;
    if (__builtin_expect(__all((pmax - m_reg) * SCALE <= THR), 1)) { mn = m_reg; alpha = 1.f; }
    else { mn = fmaxf(m_reg, pmax); alpha = __builtin_amdgcn_exp2f((m_reg - mn) * C2); m_reg = mn; }
    const float mnL = -mn * C2;
    for (int r = 0; r < 16; ++r) p0[r] = fmaf(p0[r], C2, mnL); for (int r = 0; r < 16; ++r) p1[r] = fmaf(p1[r], C2, mnL);
    for (int r = 0; r < 16; ++r) p0[r] = __builtin_amdgcn_exp2f(p0[r]);
}
__device__ __forceinline__ void finishSM(f32x16& p0, f32x16& p1, float alpha, float& l_reg, bf16x8& pa0, bf16x8& pa1, bf16x8& pa2, bf16x8& pa3) {
    for (int r = 0; r < 16; ++r) p1[r] = __builtin_amdgcn_exp2f(p1[r]);
    float ps = 0; for (int r = 0; r < 16; ++r) ps += p0[r]; for (int r = 0; r < 16; ++r) ps += p1[r];
    { auto rr = __builtin_amdgcn_permlane32_swap(__float_as_uint(ps), __float_as_uint(ps), false, false);
      ps = __uint_as_float(rr[0]) + __uint_as_float(rr[1]); }
    l_reg = l_reg * alpha + ps;
#define PK4(P, B_, OUT) do { unsigned a0 = cvtpk(P[B_+0], P[B_+1]), a1 = cvtpk(P[B_+2], P[B_+3]);                          \
        unsigned b0 = cvtpk(P[B_+4], P[B_+5]), b1 = cvtpk(P[B_+6], P[B_+7]);                                             \
        auto r0 = __builtin_amdgcn_permlane32_swap(a0, b0, false, false); auto r1 = __builtin_amdgcn_permlane32_swap(a1, b1, false, false); \
        u32x4 w = {r0[0], r1[0], r0[1], r1[1]}; OUT = *reinterpret_cast<bf16x8*>(&w); } while (0)
    PK4(p0, 0, pa0); PK4(p0, 8, pa1); PK4(p1, 0, pa2); PK4(p1, 8, pa3);
#undef PK4
}
template <int KB, bool SK>
__device__ __forceinline__ void qkt(f32x16& p0, f32x16& p1, const char* K_lds, int r32, int hi, const bf16x8* qr, bool act, const float* cbl) {
    if (SK && !act) { const float NEG = -__builtin_inff();
#pragma unroll
        for (int r = 0; r < 16; ++r) { p0[r] = NEG; p1[r] = NEG; } return; }
#pragma unroll
    for (int g_ = 0; g_ < 4; ++g_) { const f32x4 b0_ = *(const f32x4*)(cbl + KB * 64 + 8 * g_), b1_ = *(const f32x4*)(cbl + KB * 64 + 32 + 8 * g_);
#pragma unroll
        for (int e_ = 0; e_ < 4; ++e_) { p0[4 * g_ + e_] = b0_[e_]; p1[4 * g_ + e_] = b1_[e_]; } }
    const char* kb[4];
#pragma unroll
    for (int dd = 0; dd < 4; ++dd) kb[dd] = K_lds + KB * SHM_K + KSWZ(r32, (dd * 16 + hi * 8) * 2);
#pragma unroll
    for (int d0 = 0; d0 < 8; ++d0) { const char* a = kb[d0 & 3] + (d0 >> 2) * 128;
        bf16x8 b0 = *reinterpret_cast<const bf16x8*>(a);
        bf16x8 b1 = *reinterpret_cast<const bf16x8*>(a + 32 * 256);
        p0 = __builtin_amdgcn_mfma_f32_32x32x16_bf16(b0, qr[d0], p0, 0, 0, 0);
        p1 = __builtin_amdgcn_mfma_f32_32x32x16_bf16(b1, qr[d0], p1, 0, 0, 0); }
}
template <int VB, bool SK>
__device__ __forceinline__ void pv_tile(f32x16* o, int vb0, bf16x8 pa0, bf16x8 pa1, bf16x8 pa2, bf16x8 pa3, bool act) {
    if (SK && !act) return;
#define TRRD(dst, off) asm volatile("ds_read_b64_tr_b16 %0, %1 offset:%2" : "=&v"(dst) : "v"(vb0), "i"(off) : "memory")
#define PV_D0(d0) do { s16x4 l0, l1, l2, l3, h0, h1, h2, h3; constexpr int b_ = VB * SHM_V + v_rd_off(d0, 0, 0);     \
        TRRD(l0, b_); TRRD(h0, b_ + 2048); TRRD(l1, b_ + 4096); TRRD(h1, b_ + 6144); TRRD(l2, b_ + 8192); TRRD(h2, b_ + 10240); TRRD(l3, b_ + 12288); TRRD(h3, b_ + 14336); \
        asm volatile("s_waitcnt lgkmcnt(0)" ::: "memory"); SBAR();                 \
        o[d0] = __builtin_amdgcn_mfma_f32_32x32x16_bf16(pa0, (bf16x8){l0[0], l0[1], l0[2], l0[3], h0[0], h0[1], h0[2], h0[3]}, o[d0], 0, 0, 0);   \
        o[d0] = __builtin_amdgcn_mfma_f32_32x32x16_bf16(pa1, (bf16x8){l1[0], l1[1], l1[2], l1[3], h1[0], h1[1], h1[2], h1[3]}, o[d0], 0, 0, 0);   \
        o[d0] = __builtin_amdgcn_mfma_f32_32x32x16_bf16(pa2, (bf16x8){l2[0], l2[1], l2[2], l2[3], h2[0], h2[1], h2[2], h2[3]}, o[d0], 0, 0, 0);   \
        o[d0] = __builtin_amdgcn_mfma_f32_32x32x16_bf16(pa3, (bf16x8){l3[0], l3[1], l3[2], l3[3], h3[0], h3[1], h3[2], h3[3]}, o[d0], 0, 0, 0); } while (0)
    PV_D0(0); PV_D0(1); PV_D0(2); PV_D0(3);
#undef PV_D0
#undef TRRD
}

template <class TIn, class TOut> struct BlockRef { const TIn* Q; const TIn* K; const TIn* V; TOut* O; const float* C; int P0; };
template <class TIn> struct Seam {
    bf16x8 qr[8];
    bf16x8 st_v0, st_v1, st_k0, st_k1; f32x4 sf0, sf1, sf2, sf3;
    f32x4 tq[16];
};
__device__ __forceinline__ int swa_jlo(int P0, int W) { const int lowk = P0 - W + 1; return lowk > 0 ? lowk / KVBLK : 0; }
#define ROW(p, k0, rr) ((p) + (size_t)((k0) + (rr)) * LDQ + sc)
#define UROW(p, k0) ((const char*)(p) + (size_t)(k0) * (LDQ * 2))
#define LD16(ub, vo) (*(const bf16x8*)((ub) + (vo)))
#define CDMA(Cp, k0, bf) __builtin_amdgcn_global_load_lds((const unsigned*)((const char*)((Cp) + (k0)) + lane4), (__attribute__((address_space(3))) unsigned*)(lds + WS_OFF + wid * WS_W + 256 + (bf) * 256), 4, 0, 0)
#define VMW() asm volatile("s_waitcnt vmcnt(0)" ::: "memory")
#define VMWN(n) asm volatile("s_waitcnt vmcnt(%0)" :: "i"(n) : "memory")
#define SLOAD_H(Kp, Vp, k0, Cp, bf) do { S.st_v0 = LD16(UROW(Vp, k0), toff); S.st_v1 = LD16(UROW(Vp, (k0) + 32), toff);              \
                         S.st_k0 = LD16(UROW(Kp, k0), toff); S.st_k1 = LD16(UROW(Kp, (k0) + 32), toff); } while (0)
#define SWRITE_HK(bf) do { *(bf16x8*)(K_lds + (bf) * SHM_K + kws) = S.st_k0; *(bf16x8*)(K_lds + (bf) * SHM_K + kws + 32 * 256) = S.st_k1; } while (0)
#define SWRITE_HV(bf) do { *(bf16x8*)(V_lds + (bf) * SHM_V + vst0) = S.st_v0; *(bf16x8*)(V_lds + (bf) * SHM_V + vst1) = S.st_v1; } while (0)
#define SWRITE_H(bf) do { SWRITE_HV(bf); SWRITE_HK(bf); } while (0)
#define SLOAD_F(p, k0) do { S.sf0 = *(const f32x4*)ROW(p, k0, sr); S.sf1 = *(const f32x4*)(ROW(p, k0, sr) + 4);                \
                            S.sf2 = *(const f32x4*)ROW(p, k0, 32 + sr); S.sf3 = *(const f32x4*)(ROW(p, k0, 32 + sr) + 4); } while (0)
#define SWRITE_KF(bf) do { *(bf16x8*)(K_lds + (bf) * SHM_K + kws) = pack8(S.sf0, S.sf1); *(bf16x8*)(K_lds + (bf) * SHM_K + kws + 32 * 256) = pack8(S.sf2, S.sf3); } while (0)
#define SWRITE_VF(bf) do { *(bf16x8*)(V_lds + (bf) * SHM_V + vst0) = pack8(S.sf0, S.sf1); *(bf16x8*)(V_lds + (bf) * SHM_V + vst1) = pack8(S.sf2, S.sf3); } while (0)
template <class TIn, class TOut>
__device__ __forceinline__ void causal_swa_prime(const BlockRef<TIn, TOut>& cur, int W, char* lds, Seam<TIn>& S) {
    constexpr bool F32 = same_t<TIn, float>::v;
    const int tid = threadIdx.x, wid = __builtin_amdgcn_readfirstlane(tid >> 6), lane = tid & 63, r32 = lane & 31, hi = lane >> 5;
    const int sr = tid >> 4, sc = (tid & 15) * 8, kws = KSWZ(sr, sc * 2); char* K_lds = lds + 2 * SHM_V; const unsigned toff = (unsigned)(sr * LDQ + sc) * 2u, qoff = (unsigned)(r32 * LDQ + hi * 8) * 2u;
    const int kb0 = swa_jlo(cur.P0, W) * KVBLK;
    for (int d0 = 0; d0 < 8; ++d0) S.qr[d0] = LD16((const char*)(cur.Q + (size_t)(wid * QBLK) * LDQ + d0 * 16), qoff);
    if constexpr (F32) { SLOAD_F((const float*)cur.K, kb0); VMW(); SWRITE_KF(0); SBAR(); SLOAD_F((const float*)cur.V, kb0); }
    else { const unsigned lane4 = (unsigned)lane * 4u; SLOAD_H(cur.K, cur.V, kb0, cur.C, 0); CDMA(cur.C, kb0, 0); VMW(); SWRITE_HK(0); }
    __syncthreads();
}
template <class TIn, class TOut>
__device__ __forceinline__ void causal_swa_block(const BlockRef<TIn, TOut>& cur, const BlockRef<TIn, TOut>& nxt, int skv, int W, char* lds, Seam<TIn>& S) {
    constexpr bool F32 = same_t<TIn, float>::v;
    const int tid = threadIdx.x, wid = __builtin_amdgcn_readfirstlane(tid >> 6), lane = tid & 63, r32 = lane & 31, hi = lane >> 5;
    const int j_lo = swa_jlo(cur.P0, W);
    int j_hi = (cur.P0 + QB - 1) / KVBLK + 1; if (j_hi > skv / KVBLK) j_hi = skv / KVBLK;
    const int NT = j_hi - j_lo;
    const int kbn = swa_jlo(nxt.P0, W) * KVBLK;
    const int qlo = cur.P0 + wid * QBLK, qm = qlo + r32 - 4 * hi;
    char* V_lds = lds; char* K_lds = lds + 2 * SHM_V;
    const unsigned lane4 = (unsigned)lane * 4u;
    float* ws = (float*)(lds + WS_OFF + wid * WS_W); float* li_l = ws, * al_l = ws + 32;
    const float* cbl = al_l + 32 + 4 * hi;
    float m_reg = -1e30f, l_reg = 0; f32x16 o[4] = {};
    const unsigned toff = (unsigned)((tid >> 4) * LDQ + (tid & 15) * 8) * 2u, qoff = (unsigned)(r32 * LDQ + hi * 8) * 2u;
    const int sr = tid >> 4, sc = (tid & 15) * 8, vst0 = v_st(sr, sc), vst1 = vst0 + 8192  , kws = KSWZ(sr, sc * 2);
    const int vb0 = (int)(uintptr_t)V_lds + v_rd_base(lane);
    const TIn* Kh = cur.K; const TIn* Vh = cur.V;
#define RESC(a) do { if (__any((a) < 1.f)) { if (hi == 0) al_l[r32] = (a); asm volatile("s_waitcnt lgkmcnt(0)" ::: "memory");              \
                     for (int d_ = 0; d_ < 4; ++d_) for (int r = 0; r < 16; ++r) o[d_][r] *= al_l[crow(r, hi)]; } } while (0)
#define KBASE(t) ((j_lo + (t)) * KVBLK)
#define ACT(t) (KBASE(t) <= qlo + QBLK - 1 && KBASE(t) + KVBLK - 1 >= qlo - W + 1)
#define MASKT(P0_, P1_, t) do { const int kb_ = KBASE(t); if ((!SK || ACT(t)) && (kb_ + KVBLK - 1 > qlo || kb_ <= qlo + QBLK - 1 - W)) mask_tile(P0_, P1_, qm - kb_, (unsigned)W); } while (0)
    constexpr int NQL = F32 ? 16 : 8;
    constexpr bool SK = WSKIP && !F32;
#define SEAM_K0() do { VMWN(NQL); if constexpr (F32) { SWRITE_KF(0); SBAR(); SLOAD_F((const float*)nxt.V, kbn); } else { SWRITE_HK(0); } SBAR(); } while (0)
    f32x16 pA0, pA1, pB0, pB1; float mnA, mnB, alA, alB; bf16x8 pa0, pa1, pa2, pa3;
    if constexpr (F32) { VMW(); SWRITE_VF(0); SBAR(); } else { SWRITE_HV(0); SBAR(); }
    if (NT > 1) { if constexpr (F32) SLOAD_F((const float*)Kh, KBASE(1)); else { CDMA(cur.C, KBASE(1), 1); SLOAD_H(Kh, Vh, KBASE(1), cur.C, 1); } }
    SBAR(); qkt<0, SK>(pA0, pA1, K_lds, r32, hi, S.qr, ACT(0), cbl);
    if constexpr (F32) { if (NT > 1) { VMW(); SWRITE_KF(1); SBAR(); SLOAD_F((const float*)Vh, KBASE(1)); } }
    MASKT(pA0, pA1, 0); partialSM(pA0, pA1, m_reg, mnA, alA);
    if (NT > 1) { VMW(); if constexpr (F32) { SWRITE_VF(1); SBAR(); if (NT > 2) SLOAD_F((const float*)Kh, KBASE(2)); } else SWRITE_H(1); }
    __syncthreads();
#define HALF_STEP(PX0, PX1, mnX, alX, PY0, PY1, alY, t, KB, VB, SB) do {                                                      \
        if ((t) + 1 < NT) CDMA(cur.C, KBASE((t) + 1), SB);                                                                   \
        SBAR(); qkt<KB, SK>(PX0, PX1, K_lds, r32, hi, S.qr, ACT(t), cbl);                                             \
        finishSM(PY0, PY1, alY, l_reg, pa0, pa1, pa2, pa3); SBAR();                                                           \
        if ((t) + 1 < NT) { if constexpr (F32) { VMW(); SWRITE_KF(SB); SBAR(); SLOAD_F((const float*)Vh, KBASE((t) + 1)); }  \
                            else { SLOAD_H(Kh, Vh, KBASE((t) + 1), cur.C, SB); } SBAR(); }                                               \
        pv_tile<VB, SK>(o, vb0, pa0, pa1, pa2, pa3, ACT((t) - 1)); MASKT(PX0, PX1, (t)); partialSM(PX0, PX1, m_reg, mnX, alX);                                        \
        __syncthreads();                                                                                                      \
        if ((t) + 1 < NT) { VMW(); if constexpr (F32) { SWRITE_VF(SB); SBAR(); if ((t) + 2 < NT) SLOAD_F((const float*)Kh, KBASE((t) + 2)); } \
                            else { SWRITE_H(SB); } }                                                                          \
        RESC(alX); __syncthreads(); } while (0)
    for (int t = 1; t + 1 < NT; t += 2) {
        HALF_STEP(pB0, pB1, mnB, alB, pA0, pA1, alA, t, 1, 0, 0);
        HALF_STEP(pA0, pA1, mnA, alA, pB0, pB1, alB, t + 1, 0, 1, 1);
    }
    const bool even = (NT & 1) == 0;
    if (even) { SBAR(); qkt<1, SK>(pB0, pB1, K_lds, r32, hi, S.qr, ACT(NT - 1), cbl); SBAR(); }
#define QROW(e) (nxt.Q + (size_t)(wid * QBLK + r32) * D + ((e) >> 1) * 16 + hi * 8 + ((e) & 1) * 4)
    if constexpr (F32) { SLOAD_F((const float*)nxt.K, kbn); SBAR();
#pragma unroll
        for (int e = 0; e < 8; ++e) S.tq[e] = *(const f32x4*)QROW(e); }
    else { SLOAD_H(nxt.K, nxt.V, kbn, nxt.C, 0); CDMA(nxt.C, kbn, 0); SBAR();
#pragma unroll
        for (int d0 = 0; d0 < 8; ++d0) S.qr[d0] = LD16((const char*)(nxt.Q + (size_t)(wid * QBLK) * LDQ + d0 * 16), qoff); }
    SBAR();
    finishSM(pA0, pA1, alA, l_reg, pa0, pa1, pa2, pa3); SBAR();
    if constexpr (F32) {
#pragma unroll
        for (int e = 8; e < 16; ++e) S.tq[e] = *(const f32x4*)QROW(e); SBAR(); }
#undef QROW
    pv_tile<0, SK>(o, vb0, pa0, pa1, pa2, pa3, ACT(even ? NT - 2 : NT - 1));
    if (even) { MASKT(pB0, pB1, NT - 1); partialSM(pB0, pB1, m_reg, mnB, alB); __syncthreads(); RESC(alB);
        finishSM(pB0, pB1, alB, l_reg, pa0, pa1, pa2, pa3); SBAR(); pv_tile<1, SK>(o, vb0, pa0, pa1, pa2, pa3, ACT(NT - 1)); }
    SBAR(); SEAM_K0();
    if (hi == 0) li_l[r32] = l_reg; asm volatile("s_waitcnt lgkmcnt(0)" ::: "memory");
    float rli[16];
#pragma unroll
    for (int r = 0; r < 16; ++r) rli[r] = __builtin_amdgcn_rcpf(li_l[crow(r, hi)]);
    TOut* Ow = cur.O + (size_t)(wid * QBLK) * LDO;
#pragma unroll
    for (int r = 0; r < 16; ++r) { const int orow = crow(r, hi);
#pragma unroll
        for (int d0 = 0; d0 < 4; ++d0) { const float v = o[d0][r] * rli[r];
            if constexpr (same_t<TOut, float>::v) { Ow[(size_t)orow * LDO + d0 * 32 + r32] = v; }
            else { const float vn = __shfl_xor(v, 1);
                   if ((r32 & 1) == 0) *(unsigned*)(Ow + (size_t)orow * LDO + d0 * 32 + r32) = cvtpk(v, vn); } } }
    if constexpr (F32) {
#pragma unroll
        for (int d0 = 0; d0 < 8; ++d0) S.qr[d0] = pack8(S.tq[2 * d0], S.tq[2 * d0 + 1]); }
    __syncthreads();
#undef RESC
#undef KBASE
#undef ACT
#undef MASKT
#undef SEAM_K0
#undef HALF_STEP
}
#undef ROW
#undef VMW
#undef VMWN
#undef SLOAD_H
#undef SWRITE_HK
#undef SWRITE_HV
#undef SWRITE_H
#undef SLOAD_F
#undef SWRITE_KF
#undef SWRITE_VF

}

#define LAS __attribute__((address_space(3)))
typedef unsigned short bf16;
typedef float f32x4 __attribute__((ext_vector_type(4)));
typedef float f32x2 __attribute__((ext_vector_type(2)));
typedef unsigned u32x4 __attribute__((ext_vector_type(4)));
typedef unsigned u32x2 __attribute__((ext_vector_type(2)));
typedef __bf16 bf16x2_t __attribute__((ext_vector_type(2)));

constexpr int DM = 2048, NBATCH = 2, SEQ = 8192, NMETA = 16, T = SEQ + NMETA  , TP = 8448  ;
constexpr int MROWS = NBATCH * TP  , NTOK = NBATCH * T;
constexpr int LDZ0 = 3072, LDZ1 = 6144;
constexpr int NEXP = 32, DEXP = 512, NBLK_MAX = 161, RMAX = NBLK_MAX * 256;
constexpr int NCHUNK = 129, NCH = 2 * 8 * NCHUNK  ;
constexpr float EPS = 1e-6f;
constexpr int NWAVES = 8, NTHR = 512;

constexpr size_t MiB = 1u << 20;
constexpr size_t WS_CTL = 0;
constexpr size_t WS_READY = 32 * 1024;
constexpr size_t WS_BAR = 64 * 1024;
constexpr size_t WS_TOKINFO = 1 * MiB;
constexpr size_t WS_ROWTOK = 1 * MiB + 640 * 1024;
constexpr size_t WS_LOGF = 2 * MiB;
constexpr size_t WS_CB = 3 * MiB;
constexpr size_t WS_GB = 4 * MiB;
constexpr size_t WS_BB = 5 * MiB;
constexpr size_t WS_XW = 6 * MiB;
constexpr size_t WS_LRUA = 7 * MiB, WS_LRUB = 8 * MiB + 512 * 1024, WS_LRUC = 10 * MiB;
constexpr size_t WS_DUMP = 14 * MiB;
constexpr size_t WS_GT = 12 * MiB;
constexpr size_t WS_LRUW = 13 * MiB;
constexpr size_t WS_W0IN = 16 * MiB, WS_W0OUT = 36 * MiB, WS_W1IN = 44 * MiB, WS_W1OUT = 68 * MiB;
constexpr size_t WS_WGU = 80 * MiB, WS_WD = 208 * MiB;
constexpr size_t WS_H = 272 * MiB;
constexpr size_t WS_HN = 404 * MiB;
constexpr size_t WS_A2 = 470 * MiB;
constexpr size_t WS_Z = 536 * MiB;
constexpr size_t WS_U = 636 * MiB;
constexpr size_t WS_XS = 734 * MiB;
constexpr size_t WS_HID = 895 * MiB;
constexpr size_t WS_GU = 734 * MiB, WS_GW = 767 * MiB, WS_GQD = 800 * MiB, WS_GKD = 833 * MiB, WS_GATT = 866 * MiB;
constexpr size_t WS_O = 883 * MiB;
constexpr size_t WS_HL = 949 * MiB, WS_PP = 982 * MiB;
constexpr size_t WS_END = 1015 * MiB;

constexpr int LDS_BYTES = 155648;
constexpr int MISC_OFF = 131072 + 16384;

struct TokInfo { int e1, e2; float w1, w2; int pos1, pos2, s1, s2; };

struct Params { const float* in[32]; float* out; unsigned char* ws; int ph_lo, ph_hi; };

#define LBAR() do { asm volatile("s_waitcnt lgkmcnt(0)" ::: "memory"); __builtin_amdgcn_s_barrier(); asm volatile("" ::: "memory"); } while (0)
__device__ __forceinline__ unsigned pk2(float lo, float hi) { const f32x2 v = {lo, hi}; return __builtin_bit_cast(unsigned, __builtin_convertvector(v, bf16x2_t)); }
__device__ __forceinline__ unsigned f2bf(float f) { return pk2(f, f) & 0xffffu; }
__device__ __forceinline__ float bf2f(unsigned short b) { return __builtin_bit_cast(float, (unsigned)b << 16); }
__device__ __forceinline__ float bflo(unsigned w) { return __builtin_bit_cast(float, w << 16); }
__device__ __forceinline__ float bfhi(unsigned w) { return __builtin_bit_cast(float, w & 0xffff0000u); }
__device__ __forceinline__ float dot2bf(unsigned a, unsigned b, float c) { asm volatile("" : "+v"(a), "+v"(b)); return __builtin_amdgcn_fdot2_f32_bf16(__builtin_bit_cast(bf16x2_t, a), __builtin_bit_cast(bf16x2_t, b), c, false); }
#define DPPF(v, ctrl, rowmask) __builtin_bit_cast(float, __builtin_amdgcn_update_dpp(0, __builtin_bit_cast(int, (v)), (ctrl), (rowmask), 0xf, false))
__device__ __forceinline__ float row16_sum(float v) { v += DPPF(v, 0xB1, 0xf); v += DPPF(v, 0x4E, 0xf); v += DPPF(v, 0x141, 0xf); v += DPPF(v, 0x140, 0xf); return v; }
__device__ __forceinline__ float wave_sum(float v) {
    v = row16_sum(v);
    v += DPPF(v, 0x142, 0xa); v += DPPF(v, 0x143, 0xc);
    return __builtin_bit_cast(float, __builtin_amdgcn_readlane(__builtin_bit_cast(int, v), 63));
}
__device__ __forceinline__ float sigmoidf_(float x) { return __builtin_amdgcn_rcpf(1.0f + __expf(-x)); }
__device__ __forceinline__ float siluf_(float x) { return x * __builtin_amdgcn_rcpf(1.0f + __expf(-x)); }
__device__ __forceinline__ float softplusf_(float x) { return fmaxf(x, 0.f) + log1pf(__expf(-fabsf(x))); }
__device__ __forceinline__ float geluf_tanh(float x) { const float u = 0.7978845608028654f * (x + 0.044715f * x * x * x); return x * __builtin_amdgcn_rcpf(1.0f + __expf(-2.0f * u)); }

struct TrDesc { const float* src; bf16* dst; int ldw, K, scol, drow, k0; };
__device__ __forceinline__ void tr_load(const TrDesc& d, f32x2 (&v)[32], int lane) {
    const float* s = d.src + (size_t)(d.k0 + (lane >> 5)) * d.ldw + d.scol + 2 * (lane & 31);
#pragma unroll
    for (int i = 0; i < 32; ++i) v[i] = *(const f32x2*)(s + (size_t)(2 * i) * d.ldw);
}
__device__ __forceinline__ void tr_store(const TrDesc& d, const f32x2 (&v)[32], LAS float* scr, int lane) {
#pragma unroll
    for (int i = 0; i < 32; ++i) { LAS float* q = scr + (2 * i + (lane >> 5)) * 65 + 2 * (lane & 31); q[0] = v[i].x; q[1] = v[i].y; }
    asm volatile("s_waitcnt lgkmcnt(0)" ::: "memory");
    const int c = lane & 7;
#pragma unroll
    for (int j = 0; j < 8; ++j) { const int n = (lane >> 3) + 8 * j; const LAS float* s = scr + (8 * c) * 65 + n;
        u32x4 o; o.x = pk2(s[0 * 65], s[1 * 65]); o.y = pk2(s[2 * 65], s[3 * 65]); o.z = pk2(s[4 * 65], s[5 * 65]); o.w = pk2(s[6 * 65], s[7 * 65]);
        *(u32x4*)(d.dst + (size_t)(d.drow + n) * d.K + d.k0 + 8 * c) = o; }
    asm volatile("s_waitcnt lgkmcnt(0)" ::: "memory");
}
constexpr int N_DENSE_ITEMS = 32 * (48 + 32 + 32 + 48 + 48 + 32);
constexpr int N_MOE_ITEMS = NEXP * 768;
__device__ __forceinline__ TrDesc tr_decode(const Params& p, int layer, int ndense, int it) {
    unsigned char* ws = p.ws; TrDesc d;
    if (it < ndense) { int r = it; int scol0, nblk, drow0; d.K = 2048;
        if (r < 32 * 48) { d.src = p.in[5]; d.ldw = 5128; scol0 = 0; nblk = 48; d.dst = (bf16*)(ws + WS_W0IN); drow0 = 0; }
        else if ((r -= 32 * 48) < 32 * 32) { d.src = p.in[5]; d.ldw = 5128; scol0 = 3080; nblk = 32; d.dst = (bf16*)(ws + WS_W0IN); drow0 = -1; }
        else if ((r -= 32 * 32) < 32 * 32) { d.src = p.in[11]; d.ldw = 2048; scol0 = 0; nblk = 32; d.dst = (bf16*)(ws + WS_W0OUT); drow0 = 0; }
        else if ((r -= 32 * 32) < 32 * 48) { d.src = p.in[12]; d.ldw = 6160; scol0 = 0; nblk = 48; d.dst = (bf16*)(ws + WS_W1IN); drow0 = 0; }
        else if ((r -= 32 * 48) < 32 * 48) { d.src = p.in[12]; d.ldw = 6160; scol0 = 3088; nblk = 48; d.dst = (bf16*)(ws + WS_W1IN); drow0 = 3072; }
        else { r -= 32 * 48; d.src = p.in[24]; d.ldw = 2048; scol0 = 0; nblk = 32; d.dst = (bf16*)(ws + WS_W1OUT); drow0 = 0; }
        const int kb = r / nblk, nb = r - kb * nblk; d.k0 = 64 * kb; d.scol = scol0 + 64 * nb; d.drow = drow0 + 64 * nb;
        if (drow0 < 0) { const int sc = 64 * nb, isb = sc >= 1024, c = sc - 1024 * isb; d.drow = 3072 + (c >> 7) * 256 + isb * 128 + (c & 127); }
    } else { it -= ndense; const int e = it / 768; int r = it - e * 768; const size_t le = (size_t)layer * NEXP + e;
        if (r < 512) {
            const int up = r >= 256; r -= up * 256; const int kb = r / 8, nb = r - kb * 8, col = 64 * nb;
            d.src = (up ? p.in[30] : p.in[29]) + le * (size_t)(2048 * 512); d.ldw = 512; d.K = 2048; d.scol = col; d.k0 = 64 * kb;
            d.dst = (bf16*)(ws + WS_WGU) + (size_t)e * (1024 * 2048); d.drow = (col >> 7) * 256 + up * 128 + (col & 127);
        } else {
            r -= 512; const int kb = r / 32, nb = r - kb * 32;
            d.src = p.in[31] + le * (size_t)(512 * 2048); d.ldw = 2048; d.K = 512; d.scol = 64 * nb; d.k0 = 64 * kb;
            d.dst = (bf16*)(ws + WS_WD) + (size_t)e * (2048 * 512); d.drow = 64 * nb; } }
    return d;
}
__device__ __forceinline__ void convert_weights_sub(const Params& p, LAS unsigned char* lds, int layer, int ndense, int bi, int nb) {
    const int tid = threadIdx.x, lane = tid & 63, wave = __builtin_amdgcn_readfirstlane(tid >> 6);
    const int gw = bi * NWAVES + wave, NGW = nb * NWAVES, total = ndense + N_MOE_ITEMS;
    LAS float* scr = (LAS float*)(lds + wave * 16640);
    f32x2 va[32], vb[32];
    int it = gw; if (it >= total) return;
    TrDesc da = tr_decode(p, layer, ndense, it), db = da; tr_load(da, va, lane);
    for (;;) {
        const int i1 = it + NGW; if (i1 < total) { db = tr_decode(p, layer, ndense, i1); tr_load(db, vb, lane); }
        tr_store(da, va, scr, lane); if (i1 >= total) break;
        const int i2 = i1 + NGW; if (i2 < total) { da = tr_decode(p, layer, ndense, i2); tr_load(da, va, lane); }
        tr_store(db, vb, scr, lane); if (i2 >= total) break;
        it = i2;
    }
}
__device__ __forceinline__ void convert_weights(const Params& p, LAS unsigned char* lds, int layer, int ndense) { convert_weights_sub(p, lds, layer, ndense, blockIdx.x, gridDim.x); }

__device__ __forceinline__ void conv_extras(const Params& p, int gtid, int gthreads) {
    bf16* xw = (bf16*)(p.ws + WS_XW);
    for (int i = gtid; i < 8 * 2048; i += gthreads) { const int c = i >> 11, k = i & 2047; xw[i] = (bf16)f2bf(p.in[5][(size_t)k * 5128 + 3072 + c]); }
    for (int i = gtid; i < 16 * 2048; i += gthreads) { const int c = i >> 11, k = i & 2047; xw[32768 + i] = (bf16)f2bf(p.in[12][(size_t)k * 6160 + 3072 + c]); }
    { bf16* lw = (bf16*)(p.ws + WS_LRUW);
      for (int i = gtid; i < 2 * 8 * 16384; i += gthreads) { const int g = i >> 17, blk = (i >> 14) & 7, o = (i >> 7) & 127, c = i & 127; lw[i] = (bf16)f2bf((g ? p.in[21] : p.in[19])[(size_t)blk * 16384 + c * 128 + o]); } }
    for (int l = 0; l < 2; ++l) {
        bf16* wr = xw + 65536 + l * (96 * 1024);
        for (int i = gtid; i < 36 * 2048; i += gthreads) { const int c = i >> 11, k = i & 2047;
            const float v = c < 4 ? p.in[25][(size_t)l * 2048 * 4 + k * 4 + c] : p.in[27][(size_t)l * 2048 * 32 + k * 32 + (c - 4)];
            wr[i] = (bf16)f2bf(v); }
    }
}

template <int MODE, int ABL = 0> __device__ __forceinline__ void norm_phase(const Params& p, LAS unsigned char* lds, int layer) {
    const int tid = threadIdx.x, lane = tid & 63, wave = __builtin_amdgcn_readfirstlane(tid >> 6);
    unsigned char* ws = p.ws;
    constexpr int NCOL = MODE == 0 ? 8 : MODE == 1 ? 36 : MODE == 2 ? 16 : 0;
    if (MODE == 0) {
        for (int i = tid; i < 8 * 2048; i += NTHR) { const int k = i >> 3, c = i & 7; ((LAS bf16*)lds)[c * 2048 + k] = (bf16)f2bf(p.in[5][(size_t)k * 5128 + 3072 + c]); }
        __syncthreads();
    } else if (NCOL) {
        const bf16* src = (const bf16*)(ws + WS_XW) + (MODE == 2 ? 32768 : 65536 + layer * (96 * 1024));
        for (int i = tid; i < NCOL * 2048 / 8; i += NTHR) ((LAS u32x4*)lds)[i] = ((const u32x4*)src)[i];
        if (MODE == 1 && tid < 64) ((LAS unsigned*)(lds + MISC_OFF))[tid] = 0u;
        __syncthreads();
    }
    bf16* h = (bf16*)(ws + WS_H); bf16* hn = (bf16*)(ws + WS_HN);
    const float* gain = MODE == 0 || MODE == 2 ? p.in[2] + layer * DM : MODE == 1 ? p.in[3] + layer * DM : p.in[4];
    f32x4 g4[8];
#pragma unroll
    for (int j = 0; j < 8; ++j) g4[j] = ((const f32x4*)gain)[lane + 64 * j];
    const int gw = blockIdx.x * NWAVES + wave, NGW = gridDim.x * NWAVES;
    constexpr bool COMB = (MODE == 2 || MODE == 3) && !(ABL & 1);
    const TokInfo* tinfo = (const TokInfo*)(ws + WS_TOKINFO); const bf16* yb = (const bf16*)(ws + WS_XS);
    auto rowof = [&](int tok) -> size_t { const int b = tok / T; return (size_t)b * TP + (tok - b * T); };
    auto issue_h = [&](int tok, f32x4 (&v)[8]) { const int b = tok / T, t = tok - b * T;
        if (MODE == 0) { const float* src = t < NMETA ? p.in[1] + (size_t)t * DM : p.in[0] + ((size_t)b * SEQ + (t - NMETA)) * DM;
#pragma unroll
            for (int j = 0; j < 8; ++j) v[j] = ((const f32x4*)src)[lane + 64 * j]; }
        else { const u32x2* src = (const u32x2*)(h + ((size_t)b * TP + t) * DM);
#pragma unroll
            for (int j = 0; j < 8; ++j) { const u32x2 w = src[lane + 64 * j]; v[j] = (f32x4){bflo(w.x), bfhi(w.x), bflo(w.y), bfhi(w.y)}; } } };
    auto issue_y = [&](const TokInfo& ti, u32x2 (&a)[8], u32x2 (&c)[8]) { const u32x2* y1 = (const u32x2*)(yb + (size_t)ti.s1 * DM); const u32x2* y2 = (const u32x2*)(yb + (size_t)ti.s2 * DM);
#pragma unroll
        for (int j = 0; j < 8; ++j) { a[j] = y1[lane + 64 * j]; c[j] = y2[lane + 64 * j]; } };
    f32x4 v[8], vn[8]; u32x2 ya[8], yc[8], yan[8], ycn[8], hb[8]; TokInfo ti{}, tin{}, tin2{};
    if (gw < NTOK) { issue_h(gw, v);
        if (COMB) { ti = tinfo[rowof(gw)]; issue_y(ti, ya, yc); if (gw + NGW < NTOK) tin = tinfo[rowof(gw + NGW)]; } }
    for (int tok = gw; tok < NTOK; tok += NGW) {
        const int b = tok / T, t = tok - b * T; const size_t row = (size_t)b * TP + t;
        const int nt = tok + NGW;
        if (nt < NTOK) { issue_h(nt, vn); if (COMB) { issue_y(tin, yan, ycn); if (nt + NGW < NTOK) tin2 = tinfo[rowof(nt + NGW)]; } }
        if (COMB) {
#pragma unroll
            for (int j = 0; j < 8; ++j) { const u32x2 a = ya[j], c = yc[j];
                v[j][0] += ti.w1 * bflo(a.x) + ti.w2 * bflo(c.x); v[j][1] += ti.w1 * bfhi(a.x) + ti.w2 * bfhi(c.x);
                v[j][2] += ti.w1 * bflo(a.y) + ti.w2 * bflo(c.y); v[j][3] += ti.w1 * bfhi(a.y) + ti.w2 * bfhi(c.y); }
        }
        if (MODE == 0 || MODE == 2) {
#pragma unroll
            for (int j = 0; j < 8; ++j) { u32x2 w; w.x = pk2(v[j][0], v[j][1]); w.y = pk2(v[j][2], v[j][3]); ((u32x2*)(h + row * DM))[lane + 64 * j] = w; }
        }
        float ss = 0.f;
#pragma unroll
        for (int j = 0; j < 8; ++j) ss += (v[j][0] * v[j][0] + v[j][1] * v[j][1]) + (v[j][2] * v[j][2] + v[j][3] * v[j][3]);
        const float rstd = rsqrtf(wave_sum(ss) * (1.0f / DM) + EPS);
#pragma unroll
        for (int j = 0; j < 8; ++j) v[j] = v[j] * rstd * g4[j];
        if (MODE == 3) {
            if (t >= NMETA && (!(ABL & 2) || v[0][0] == 1.2345e33f)) { float* o = p.out + ((size_t)b * SEQ + (t - NMETA)) * DM;
#pragma unroll
                for (int j = 0; j < 8; ++j) ((f32x4*)o)[lane + 64 * j] = v[j]; }
        } else {
#pragma unroll
            for (int j = 0; j < 8; ++j) { hb[j].x = pk2(v[j][0], v[j][1]); hb[j].y = pk2(v[j][2], v[j][3]); ((u32x2*)(hn + row * DM))[lane + 64 * j] = hb[j]; }
        }
        auto dotc = [&](int c) -> float {
            const LAS u32x2* w = (const LAS u32x2*)(lds + c * 4096) + lane; float a = 0.f;
#pragma unroll
            for (int j = 0; j < 8; ++j) { const u32x2 q = w[64 * j];
                a = dot2bf(hb[j].x, q.x, a); a = dot2bf(hb[j].y, q.y, a); }
            return wave_sum(a);
        };
        if (MODE == 0) {
            float* logf_ = (float*)(ws + WS_LOGF);
#pragma unroll 1
            for (int c = 0; c < 8; ++c) { const float x = dotc(c) + p.in[6][c]; const float lf = fminf(x, 0.f) - log1pf(__expf(-fabsf(x)));
                if (lane == 0) logf_[(size_t)(b * 8 + c) * TP + t] = lf; }
        }
        if (MODE == 2) {
            float* gb = (float*)(ws + WS_GB); float* bb = (float*)(ws + WS_BB);
#pragma unroll 1
            for (int c = 0; c < 8; ++c) { const float a_in = dotc(c), b_in = dotc(8 + c);
                const float g = -__expf(p.in[14][c]) * softplusf_(a_in + p.in[15][c]), be = sigmoidf_(b_in);
                if (lane == 0) { gb[row * 8 + c] = g; bb[row * 8 + c] = be; } }
        }
        if (MODE == 1) {
            const float* bg = p.in[26] + layer * 4; const float* be = p.in[28] + layer * NEXP;
            int gs = 0; float gm = -3.0e38f, gsum = 0.f;
#pragma unroll 1
            for (int c = 0; c < 4; ++c) { const float l = dotc(c) + bg[c];
                if (l > gm) { gsum = gsum * __expf(gm - l) + 1.0f; gm = l; gs = c; } else gsum += __expf(l - gm); }
            const float gprob = 1.0f / gsum;
            gs = __builtin_amdgcn_readfirstlane(gs);
            int i1 = 0, i2 = 0; float m1 = -3.0e38f, m2 = -3.0e38f;
#pragma unroll 1
            for (int c = 0; c < 8; ++c) { const float l = dotc(4 + gs * 8 + c) + be[gs * 8 + c];
                if (l > m1) { m2 = m1; i2 = i1; m1 = l; i1 = c; } else if (l > m2) { m2 = l; i2 = c; } }
            const float e2 = __expf(m2 - m1), den = 1.0f / (1.0f + e2);
            if (lane == 0) {
                LAS unsigned* lcnt = (LAS unsigned*)(lds + MISC_OFF);
                TokInfo to; to.e1 = gs * 8 + i1; to.e2 = gs * 8 + i2; to.w1 = gprob * den; to.w2 = gprob * e2 * den;
                to.pos1 = (int)__hip_atomic_fetch_add(lcnt + to.e1, 1u, __ATOMIC_RELAXED, __HIP_MEMORY_SCOPE_WORKGROUP); to.pos2 = (int)__hip_atomic_fetch_add(lcnt + to.e2, 1u, __ATOMIC_RELAXED, __HIP_MEMORY_SCOPE_WORKGROUP); to.s1 = 0; to.s2 = 0;
                ((TokInfo*)(ws + WS_TOKINFO))[row] = to;
            }
        }
        if (nt < NTOK) {
#pragma unroll
            for (int j = 0; j < 8; ++j) { v[j] = vn[j]; if (COMB) { ya[j] = yan[j]; yc[j] = ycn[j]; } }
            if (COMB) { ti = tin; tin = tin2; } }
    }
    if (MODE == 1) {
        LAS unsigned* lcnt = (LAS unsigned*)(lds + MISC_OFF);
        __syncthreads();
        if (tid < NEXP) { const unsigned c = lcnt[tid]; lcnt[32 + tid] = c ? atomicAdd((unsigned*)(ws + WS_CTL) + 64 * tid, c) : 0u; }
        __syncthreads();
        if (lane == 0) for (int tok = gw; tok < NTOK; tok += NGW) { TokInfo* tp = (TokInfo*)(ws + WS_TOKINFO) + rowof(tok); tp->pos1 += (int)lcnt[32 + tp->e1]; tp->pos2 += (int)lcnt[32 + tp->e2]; }
    }
}

__device__ __forceinline__ void moe_offsets(const unsigned* cnt, LAS int* tab  ) {
    if (threadIdx.x == 0) { int acc = 0, nb = 0;
        for (int e = 0; e < NEXP; ++e) { const int c = (int)cnt[64 * e], pb = (c + 255) >> 8; tab[e] = acc; tab[32 + e] = c; for (int q = 0; q < pb; ++q) tab[65 + nb + q] = e; nb += pb; acc += pb * 256; }
        tab[64] = nb; }
    __syncthreads();
}
__device__ __forceinline__ void moe_scatter_phase(const Params& p, LAS unsigned char* lds) {
    const int tid = threadIdx.x;
    unsigned char* ws = p.ws; LAS int* tab = (LAS int*)(lds + MISC_OFF);
    moe_offsets((const unsigned*)(ws + WS_CTL), tab);
    int* rowtok = (int*)(ws + WS_ROWTOK);
    const int gt = blockIdx.x * NTHR + tid, GT = gridDim.x * NTHR;
    for (int tok = gt; tok < NTOK; tok += GT) {
        const int b = tok / T, t = tok - b * T; const int row = b * TP + t;
        TokInfo* tip = (TokInfo*)(ws + WS_TOKINFO) + row; const TokInfo ti = *tip;
        const int s1 = tab[ti.e1] + ti.pos1, s2 = tab[ti.e2] + ti.pos2;
        rowtok[s1] = row; rowtok[s2] = row; tip->s1 = s1; tip->s2 = s2;
    }
    for (int e = 0; e < NEXP; ++e) { const int c = tab[32 + e], r0 = tab[e] + c, r1 = tab[e] + ((c + 255) & ~255);
        for (int r = r0 + gt; r < r1; r += GT) rowtok[r] = T; }
}

__device__ __forceinline__ void fox_cumsum(const Params& p, LAS unsigned char* lds, int bh) {
    const int tid = threadIdx.x; const float* lf = (const float*)(p.ws + WS_LOGF) + (size_t)bh * TP; float* cb = (float*)(p.ws + WS_CB) + (size_t)bh * TP;
    LAS double* part = (LAS double*)lds;
    constexpr int PER = 17;
    double s = 0.0; const int i0 = tid * PER;
    for (int i = 0; i < PER; ++i) { const int t = i0 + i; if (t < T) s += (double)lf[t]; }
    part[tid] = s; __syncthreads();
    for (int o = 1; o < NTHR; o <<= 1) { const double a = tid >= o ? part[tid - o] : 0.0; __syncthreads(); part[tid] += a; __syncthreads(); }
    double run = tid ? part[tid - 1] : 0.0;
    for (int i = 0; i < PER; ++i) { const int t = i0 + i; if (t < T) { run += (double)lf[t]; cb[t] = (float)(-run * 11.313708498984761); } else if (t < TP) cb[t] = 0.f; }
    __syncthreads();
}

__device__ __forceinline__ void conv_phase(const Params& p, LAS unsigned char* lds) {
    const int tid = threadIdx.x, lane = tid & 63, wave = __builtin_amdgcn_readfirstlane(tid >> 6);
    const bf16* ug = (const bf16*)(p.ws + WS_U); bf16* a2 = (bf16*)(p.ws + WS_A2);
    const float* cw = p.in[7]; const float* cbias = p.in[8]; const float* lng = p.in[9]; const float* lnb = p.in[10];
    LAS unsigned char* ub = lds;
    LAS float* yb = (LAS float*)(lds + 38 * 2048);
    const int ch = 2 * tid;
    float w0[31], w1[31];
#pragma unroll
    for (int j = 0; j < 31; ++j) { const f32x2 w = *(const f32x2*)(cw + j * 1024 + ch); w0[j] = w.x; w1[j] = w.y; }
    const f32x2 cb2 = *(const f32x2*)(cbias + ch);
    constexpr int NT8 = T / 8, NITEM = 2 * NT8;
    u32x4 pre[10];
    auto issue = [&](int item) { const int b = item / NT8, t0 = (item - b * NT8) * 8;
#pragma unroll
        for (int k = 0; k < 10; ++k) { const int e = tid + NTHR * k, r = e >> 7, c = e & 127, t = t0 - 30 + r; pre[k] = (u32x4){0u, 0u, 0u, 0u};
            if (r < 38 && t >= 0) pre[k] = *(const u32x4*)(ug + ((size_t)b * TP + t) * 1024 + c * 8); } };
    int item = blockIdx.x;
    if (item < NITEM) issue(item);
    for (; item < NITEM; item += gridDim.x) {
        const int b = item / NT8, t0 = (item - b * NT8) * 8;
#pragma unroll
        for (int k = 0; k < 10; ++k) { const int e = tid + NTHR * k; if (e < 38 * 128) *(LAS u32x4*)(ub + e * 16) = pre[k]; }
        LBAR();
        if (item + (int)gridDim.x < NITEM) issue(item + gridDim.x);
        float a0[8], a1[8];
#pragma unroll
        for (int q = 0; q < 8; ++q) { a0[q] = cb2.x; a1[q] = cb2.y; }
#pragma unroll
        for (int r = 0; r < 38; ++r) { const unsigned uu = *(const LAS unsigned*)(ub + r * 2048 + ch * 2); const float u0 = bflo(uu), u1 = bfhi(uu);
#pragma unroll
            for (int q = 0; q < 8; ++q) { const int j = r - q; if (j >= 0 && j < 31) { a0[q] += w0[j] * u0; a1[q] += w1[j] * u1; } } }
#pragma unroll
        for (int q = 0; q < 8; ++q) *(LAS f32x2*)(yb + q * 1024 + ch) = (f32x2){a0[q], a1[q]};
        LBAR();
        { const int q = wave, t = t0 + q;
          f32x4 v[4]; float s = 0.f;
#pragma unroll
          for (int j = 0; j < 4; ++j) { v[j] = *(const LAS f32x4*)(yb + q * 1024 + 4 * lane + 256 * j); s += (v[j][0] + v[j][1]) + (v[j][2] + v[j][3]); }
          const float mu = wave_sum(s) * (1.0f / 1024.0f); float s2 = 0.f;
#pragma unroll
          for (int j = 0; j < 4; ++j) { v[j] = v[j] - mu; s2 += (v[j][0] * v[j][0] + v[j][1] * v[j][1]) + (v[j][2] * v[j][2] + v[j][3] * v[j][3]); }
          const float rstd = rsqrtf(wave_sum(s2) * (1.0f / 1024.0f) + EPS);
          bf16* orow = a2 + ((size_t)b * TP + t) * DM + 1024;
#pragma unroll
          for (int j = 0; j < 4; ++j) { const f32x4 g = *(const f32x4*)(lng + 4 * lane + 256 * j), bb = *(const f32x4*)(lnb + 4 * lane + 256 * j);
              const f32x4 y = v[j] * rstd * g + bb;
              u32x2 w; w.x = pk2(siluf_(y[0]), siluf_(y[1])); w.y = pk2(siluf_(y[2]), siluf_(y[3])); *(u32x2*)(orow + 4 * lane + 256 * j) = w; } }
        LBAR();
    }
}

typedef att::BlockRef<att::bf16, att::bf16> ABlock;
__device__ __forceinline__ ABlock att_block(const Params& p, int bh, int qb) {
    const int b = bh >> 3, hh = bh & 7; const bf16* z = (const bf16*)(p.ws + WS_Z); const size_t row0 = (size_t)b * TP;
    ABlock r; r.Q = z + (row0 + (size_t)qb * 256) * LDZ0 + hh * 128; r.K = z + row0 * LDZ0 + 1024 + hh * 128; r.V = z + row0 * LDZ0 + 2048 + hh * 128;
    r.O = (bf16*)(p.ws + WS_A2) + (row0 + (size_t)qb * 256) * DM + hh * 128; r.C = (const float*)(p.ws + WS_CB) + (size_t)bh * TP; r.P0 = qb * 256; return r;
}
__device__ __forceinline__ bool att_stream(int G, int c, int idx, int& bh, int& qb) {
    int L = c;
    for (;;) { if (L >= 272) return false; const int nb = L < 256 ? 2 : 1; if (idx < nb) break; idx -= nb; L += G; }
    if (L < 256) { bh = L >> 4; const int x = L & 15; qb = idx ? 32 - x : 1 + x; } else { bh = L - 256; qb = 0; }
    return true;
}
__device__ __forceinline__ void mix0_phase(const Params& p, LAS unsigned char* lds) {
    const int G = gridDim.x, c = blockIdx.x;
    int bh, qb;
    if (att_stream(G, c, 0, bh, qb)) {
        att::Seam<att::bf16> S;
        ABlock cur = att_block(p, bh, qb);
        att::causal_swa_prime<att::bf16, att::bf16>(cur, 1 << 30, (char*)lds, S);
        for (int idx = 0;; ++idx) {
            int bh2, qb2; const bool more = att_stream(G, c, idx + 1, bh2, qb2);
            const ABlock nxt = more ? att_block(p, bh2, qb2) : cur;
            att::causal_swa_block<att::bf16, att::bf16>(cur, nxt, TP, 1 << 30, (char*)lds, S);
            if (!more) break;
            cur = nxt;
        }
        asm volatile("s_waitcnt vmcnt(0)" ::: "memory"); __syncthreads();
    }
}
constexpr int PREP_SPLIT = 96;
#define PREP_ITEM(w) (((w) & 15) * NCHUNK + ((w) >> 4))
constexpr size_t WS_FLAG = WS_BAR + 16 * 1024;

typedef short pbf16x8 __attribute__((ext_vector_type(8)));
__device__ __forceinline__ void rot8(float (&x)[8], int k) {
    float t[8];
#pragma unroll
    for (int e = 0; e < 8; ++e) t[e] = (k & 1) ? x[(e + 1) & 7] : x[e];
#pragma unroll
    for (int e = 0; e < 8; ++e) x[e] = (k & 2) ? t[(e + 2) & 7] : t[e];
#pragma unroll
    for (int e = 0; e < 8; ++e) t[e] = (k & 4) ? x[(e + 4) & 7] : x[e];
#pragma unroll
    for (int e = 0; e < 8; ++e) x[e] = t[e];
}
struct PrepPre { u32x4 z[16]; float g, be; };
__device__ __forceinline__ void gdn_prep_issue(const Params& p, int item, PrepPre& P) {
    const int tid = threadIdx.x, lane = tid & 63;
    const int bh = item / NCHUNK, n = item - bh * NCHUNK, b = bh >> 3, hh = bh & 7;
    const bf16* z = (const bf16*)(p.ws + WS_Z);
#pragma unroll
    for (int pp = 0; pp < 4; ++pp) { const int part = pp >> 1, i = (pp & 1) * 32 + (tid >> 4), d0 = (tid & 15) * 8, t = 64 * n - 48 + i, col = part * 1024 + hh * 128 + d0;
#pragma unroll
        for (int j = 0; j < 4; ++j) { const int ts = t - 3 + j; P.z[pp * 4 + j] = (u32x4){0u, 0u, 0u, 0u};
            if (ts >= 0) P.z[pp * 4 + j] = *(const u32x4*)(z + ((size_t)b * TP + ts) * LDZ1 + col); } }
    P.g = 0.f; P.be = 0.f;
    if (tid < 64) { const int t = 64 * n - 48 + lane; if (t >= 0) { const size_t row = (size_t)b * TP + t; P.g = ((const float*)(p.ws + WS_GB))[row * 8 + hh]; P.be = ((const float*)(p.ws + WS_BB))[row * 8 + hh]; } }
}
template <int ABL = 0> __device__ __forceinline__ void gdn_prep_item(const Params& p, LAS unsigned char* lds, int item, PrepPre& P, int next) {
    const int tid = threadIdx.x, lane = tid & 63, wave = __builtin_amdgcn_readfirstlane(tid >> 6);
    const int bh = item / NCHUNK, n = item - bh * NCHUNK, b = bh >> 3, hh = bh & 7;
    unsigned char* ws = p.ws; const bf16* z = (const bf16*)(ws + WS_Z);
    constexpr int LK = 136, LT = 72;
    LAS bf16* Kb = (LAS bf16*)lds; LAS bf16* Qb = Kb + 64 * LK; LAS bf16* VbT = Qb + 64 * LK; LAS bf16* KgT = VbT + 128 * LT; LAS bf16* KdT = KgT + 128 * LT;
    LAS float* As = (LAS float*)(KdT + 128 * LT); LAS float* Ts = As + 64 * 65; LAS float* Ms = Ts + 64 * 65; LAS bf16* Tb = (LAS bf16*)(Ms + 32 * 34);
    LAS bf16* Vb = (LAS bf16*)As;
    LAS float* gcs = (LAS float*)(Tb + 64 * LT); LAS float* bes = gcs + 64; LAS float* egs = bes + 64; LAS float* ekd = egs + 64;
    const float* cw = p.in[13];
    LAS float* cwl = ekd + 64;
    for (int e = tid; e < 3 * 4 * 128; e += NTHR) { const int pj = e >> 7, d = e & 127; cwl[e] = cw[(pj & 3) * 3072 + (pj >> 2) * 1024 + hh * 128 + d]; }
    if (wave == 0) { const float g = P.g, be = P.be;
        float c = g;
#pragma unroll
        for (int o = 1; o < 64; o <<= 1) { const float u = __shfl_up(c, o); if (lane >= o) c += u; }
        const float gl = __shfl(c, 63);
        gcs[lane] = c; bes[lane] = be; egs[lane] = __expf(c); ekd[lane] = __expf(gl - c);
        if (lane == 0) ((float*)(ws + WS_GT))[item] = __expf(gl); }
    __syncthreads();
    bf16* qdg = (bf16*)(ws + WS_GQD) + (size_t)item * 8192;
#pragma unroll
    for (int pp = 0; pp < ((ABL & 2) ? 0 : (ABL & 16) ? 4 : 6); ++pp) {
        const int part = pp >> 1, i = (pp & 1) * 32 + (tid >> 4), d0 = (tid & 15) * 8, t = 64 * n - 48 + i, col = part * 1024 + hh * 128 + d0;
        float x[8];
#pragma unroll
        for (int e = 0; e < 8; ++e) x[e] = 0.f;
        if (t >= 0) {
#pragma unroll
            for (int j = 0; j < 4; ++j) { const int ts = t - 3 + j;
                if (ts >= 0) { const u32x4 zz = (pp < 4 || (ABL & 8)) ? P.z[(pp & 3) * 4 + j] : *(const u32x4*)(z + ((size_t)b * TP + ts) * LDZ1 + col); const f32x4 wa = *(const LAS f32x4*)(cwl + (part * 4 + j) * 128 + d0), wb = *(const LAS f32x4*)(cwl + (part * 4 + j) * 128 + d0 + 4);
                    x[0] += wa[0] * bflo(zz.x); x[1] += wa[1] * bfhi(zz.x); x[2] += wa[2] * bflo(zz.y); x[3] += wa[3] * bfhi(zz.y);
                    x[4] += wb[0] * bflo(zz.z); x[5] += wb[1] * bfhi(zz.z); x[6] += wb[2] * bflo(zz.w); x[7] += wb[3] * bfhi(zz.w); } }
            if (!(ABL & 32)) {
#pragma unroll
            for (int e = 0; e < 8; ++e) x[e] = siluf_(x[e]); }
        }
        float ss = 0.f;
#pragma unroll
        for (int e = 0; e < 8; ++e) ss += x[e] * x[e];
        ss = row16_sum(ss);
        const float rn = rsqrtf(ss + EPS), be = bes[i], eg = egs[i];
        if (part == 0) { const float sc = rn * 0.08838834764831845f; u32x4 w, wd;
            w.x = pk2(x[0] * sc, x[1] * sc); w.y = pk2(x[2] * sc, x[3] * sc); w.z = pk2(x[4] * sc, x[5] * sc); w.w = pk2(x[6] * sc, x[7] * sc);
            *(LAS u32x4*)(Qb + i * LK + d0) = w;
            const float sd = sc * eg; wd.x = pk2(x[0] * sd, x[1] * sd); wd.y = pk2(x[2] * sd, x[3] * sd); wd.z = pk2(x[4] * sd, x[5] * sd); wd.w = pk2(x[6] * sd, x[7] * sd);
            *(u32x4*)(qdg + i * 128 + d0) = wd;
        } else if (part == 1) { u32x4 w; w.x = pk2(x[0] * rn, x[1] * rn); w.y = pk2(x[2] * rn, x[3] * rn); w.z = pk2(x[4] * rn, x[5] * rn); w.w = pk2(x[6] * rn, x[7] * rn);
            *(LAS u32x4*)(Kb + i * LK + d0) = w;
        } else { u32x4 w; w.x = pk2(x[0] * be, x[1] * be); w.y = pk2(x[2] * be, x[3] * be); w.z = pk2(x[4] * be, x[5] * be); w.w = pk2(x[6] * be, x[7] * be);
            *(LAS u32x4*)(Vb + i * LK + d0) = w;
        }
    }
    if (next < NCH) gdn_prep_issue(p, next, P);
    LBAR();
    { const int d = tid & 127, i0 = (tid >> 7) * 16; unsigned pv[8], pg[8], pd[8];
#pragma unroll
      for (int k = 0; k < 8; ++k) { const int i = i0 + 2 * k;
          const float k0 = bf2f(Kb[i * LK + d]), k1 = bf2f(Kb[(i + 1) * LK + d]);
          pv[k] = (unsigned)Vb[i * LK + d] | ((unsigned)Vb[(i + 1) * LK + d] << 16);
          pg[k] = pk2(k0 * (bes[i] * egs[i]), k1 * (bes[i + 1] * egs[i + 1])); pd[k] = pk2(k0 * ekd[i], k1 * ekd[i + 1]); }
      *(LAS u32x4*)(VbT + d * LT + i0) = (u32x4){pv[0], pv[1], pv[2], pv[3]}; *(LAS u32x4*)(VbT + d * LT + i0 + 8) = (u32x4){pv[4], pv[5], pv[6], pv[7]};
      *(LAS u32x4*)(KgT + d * LT + i0) = (u32x4){pg[0], pg[1], pg[2], pg[3]}; *(LAS u32x4*)(KgT + d * LT + i0 + 8) = (u32x4){pg[4], pg[5], pg[6], pg[7]};
      *(LAS u32x4*)(KdT + d * LT + i0) = (u32x4){pd[0], pd[1], pd[2], pd[3]}; *(LAS u32x4*)(KdT + d * LT + i0 + 8) = (u32x4){pd[4], pd[5], pd[6], pd[7]}; }
    LBAR();
    { const int r = lane & 15, q = lane >> 4, ib = wave >> 1; bf16* attg = (bf16*)(ws + WS_GATT) + (size_t)item * 4096;
#pragma unroll
      for (int jj = 0; jj < 2; ++jj) { const int jb = (wave & 1) * 2 + jj;
          f32x4 g1 = (f32x4){0.f, 0.f, 0.f, 0.f}, g2 = g1;
          if (jb <= ib) {
#pragma unroll
              for (int s = 0; s < 4; ++s) { const pbf16x8 ak = *(const LAS pbf16x8*)(Kb + (ib * 16 + r) * LK + 32 * s + 8 * q), aq = *(const LAS pbf16x8*)(Qb + (ib * 16 + r) * LK + 32 * s + 8 * q), bk = *(const LAS pbf16x8*)(Kb + (jb * 16 + r) * LK + 32 * s + 8 * q);
                  g1 = __builtin_amdgcn_mfma_f32_16x16x32_bf16(ak, bk, g1, 0, 0, 0); g2 = __builtin_amdgcn_mfma_f32_16x16x32_bf16(aq, bk, g2, 0, 0, 0); } }
          const int j = jb * 16 + r; const float gj = gcs[j];
#pragma unroll
          for (int e = 0; e < 4; ++e) { const int i = ib * 16 + 4 * q + e; const float dec = __expf(gcs[i] - gj);
              As[i * 65 + j] = j < i ? g1[e] * dec * bes[i] : 0.f; attg[i * 64 + j] = (bf16)f2bf(j <= i ? g2[e] * dec : 0.f); } } }
    LBAR();
    if (!(ABL & 1)) {
    for (int e = tid; e < 64 * 65; e += NTHR) Ts[e] = 0.f;
    LBAR();
    if (tid < 64) { const int I = tid >> 4, c = tid & 15; float x[16];
#pragma unroll
        for (int i = 0; i < 16; ++i) { float a = (i == c) ? 1.0f : 0.0f;
#pragma unroll
            for (int j = 0; j < i; ++j) a -= As[(I * 16 + i) * 65 + I * 16 + j] * x[j];
            x[i] = a; }
#pragma unroll
        for (int i = 0; i < 16; ++i) Ts[(I * 16 + i) * 65 + I * 16 + c] = x[i]; }
    LBAR();
    { const int I = (tid >> 8) * 2 + 1, a = (tid >> 4) & 15, bq = tid & 15; float m = 0.f;
#pragma unroll
      for (int c = 0; c < 16; ++c) m += As[(I * 16 + a) * 65 + (I - 1) * 16 + c] * Ts[((I - 1) * 16 + c) * 65 + (I - 1) * 16 + bq];
      Ms[(tid >> 4) * 34 + bq] = m;
      LBAR();
      float t = 0.f;
#pragma unroll
      for (int c = 0; c < 16; ++c) t -= Ts[(I * 16 + a) * 65 + I * 16 + c] * Ms[((tid >> 8) * 16 + c) * 34 + bq];
      LBAR();
      Ts[(I * 16 + a) * 65 + (I - 1) * 16 + bq] = t; }
    LBAR();
    { float m[2];
#pragma unroll
      for (int h = 0; h < 2; ++h) { const int e = tid + NTHR * h, a = e >> 5, bq = e & 31; float v = 0.f;
#pragma unroll
          for (int c = 0; c < 32; ++c) v += As[(32 + a) * 65 + c] * Ts[c * 65 + bq];
          m[h] = v; }
#pragma unroll
      for (int h = 0; h < 2; ++h) { const int e = tid + NTHR * h; Ms[(e >> 5) * 34 + (e & 31)] = m[h]; }
      LBAR();
#pragma unroll
      for (int h = 0; h < 2; ++h) { const int e = tid + NTHR * h, a = e >> 5, bq = e & 31; float v = 0.f;
#pragma unroll
          for (int c = 0; c < 32; ++c) v -= Ts[(32 + a) * 65 + 32 + c] * Ms[c * 34 + bq];
          m[h] = v; }
      LBAR();
#pragma unroll
      for (int h = 0; h < 2; ++h) { const int e = tid + NTHR * h; Ts[(32 + (e >> 5)) * 65 + (e & 31)] = m[h]; } }
    LBAR();
    }
    for (int e = tid; e < 4096; e += NTHR) { const int i = e >> 6, j = e & 63; Tb[i * LT + j] = (bf16)f2bf(((j >> 4) < (i >> 4) || ((j >> 4) == (i >> 4) && j <= i)) ? Ts[i * 65 + j] : 0.f); }
    LBAR();
    if (!(ABL & 4)) { const int r = lane & 15, q = lane >> 4, db = wave; bf16* ug = (bf16*)(ws + WS_GU) + (size_t)item * 8192; bf16* wg = (bf16*)(ws + WS_GW) + (size_t)item * 8192;
      pbf16x8 bv[2], bk[2];
#pragma unroll
      for (int s = 0; s < 2; ++s) { bv[s] = *(const LAS pbf16x8*)(VbT + (db * 16 + r) * LT + 32 * s + 8 * q); bk[s] = *(const LAS pbf16x8*)(KgT + (db * 16 + r) * LT + 32 * s + 8 * q); }
#pragma unroll
      for (int ib = 0; ib < 4; ++ib) { f32x4 au = (f32x4){0.f, 0.f, 0.f, 0.f}, aw = au;
#pragma unroll
          for (int s = 0; s < 2; ++s) { const pbf16x8 at = *(const LAS pbf16x8*)(Tb + (ib * 16 + r) * LT + 32 * s + 8 * q);
              au = __builtin_amdgcn_mfma_f32_16x16x32_bf16(at, bv[s], au, 0, 0, 0); aw = __builtin_amdgcn_mfma_f32_16x16x32_bf16(at, bk[s], aw, 0, 0, 0); }
          u32x2 pu; pu.x = pk2(au[0], au[1]); pu.y = pk2(au[2], au[3]); *(u32x2*)(ug + (db * 16 + r) * 64 + ib * 16 + 4 * q) = pu;
#pragma unroll
          for (int e = 0; e < 4; ++e) Kb[(ib * 16 + 4 * q + e) * LK + db * 16 + r] = (bf16)f2bf(-aw[e]); }
      LBAR();
      for (int e = tid; e < 1024; e += NTHR) { const int row = e >> 4, c = e & 15; *(u32x4*)(wg + row * 128 + c * 8) = *(const LAS u32x4*)(Kb + row * LK + c * 8); } }
    if (!(ABL & 4)) { bf16* kdg = (bf16*)(ws + WS_GKD) + (size_t)item * 8192;
      for (int e = tid; e < 1024; e += NTHR) { const int row = e >> 3, c = e & 7; *(u32x4*)(kdg + row * 64 + c * 8) = *(const LAS u32x4*)(KdT + row * LT + c * 8); } }
    LBAR();
}

typedef short gbf16x8 __attribute__((ext_vector_type(8)));
struct GdnSet { u32x4 w[2], qd[2], kd[2], at, u; float gt; };
constexpr int GS_W = 0, GS_QD = 17408, GS_KD = 34816, GS_AT = 53248, GS_U = 62464, GS_SLOT = 67072;
__device__ __forceinline__ void gdn_issue(GdnSet& o, const unsigned char* ws, size_t ci, int sl, int tid) {
    const u32x4* wg = (const u32x4*)((const bf16*)(ws + WS_GW) + ci * 8192); const u32x4* qg = (const u32x4*)((const bf16*)(ws + WS_GQD) + ci * 8192); const u32x4* kg = (const u32x4*)((const bf16*)(ws + WS_GKD) + ci * 8192);
#pragma unroll
    for (int k = 0; k < 2; ++k) { o.w[k] = wg[tid + 512 * k]; o.qd[k] = qg[tid + 512 * k]; o.kd[k] = kg[tid + 512 * k]; }
    o.at = ((const u32x4*)((const bf16*)(ws + WS_GATT) + ci * 4096))[tid];
    o.u = ((const u32x4*)((const bf16*)(ws + WS_GU) + ci * 8192 + sl * 32 * 64))[tid & 255];
    o.gt = ((const float*)(ws + WS_GT))[ci];
}
__device__ __forceinline__ void gdn_put(const GdnSet& o, LAS unsigned char* slot, int tid) {
#pragma unroll
    for (int k = 0; k < 2; ++k) { const int c = tid + 512 * k;
        *(LAS u32x4*)(slot + GS_W + (c >> 4) * 272 + (c & 15) * 16) = o.w[k]; *(LAS u32x4*)(slot + GS_QD + (c >> 4) * 272 + (c & 15) * 16) = o.qd[k];
        *(LAS u32x4*)(slot + GS_KD + (c >> 3) * 144 + (c & 7) * 16) = o.kd[k]; }
    *(LAS u32x4*)(slot + GS_AT + (tid >> 3) * 144 + (tid & 7) * 16) = o.at;
    if (tid < 256) *(LAS u32x4*)(slot + GS_U + (tid >> 3) * 144 + (tid & 7) * 16) = o.u;
}
template <int ABL = 0, bool LATE = false> __device__ __forceinline__ void gdn_scan_item(const Params& p, LAS unsigned char* lds, int item) {
    const int tid = threadIdx.x, lane = tid & 63, wave = __builtin_amdgcn_readfirstlane(tid >> 6);
    const int bh = item >> 2, sl = item & 3, b = bh >> 3, hh = bh & 7;
    const int ib = wave >> 1, vb = wave & 1, kb = wave, r = lane & 15, q = lane >> 4;
    unsigned char* ws = p.ws;
    constexpr int LDS_K = 136, LDS_I = 72;
    LAS bf16* ST = (LAS bf16*)(lds + 2 * GS_SLOT); LAS bf16* VNT = ST + 32 * LDS_K;
    for (int e = tid; e < 32 * LDS_K / 2; e += NTHR) ((LAS unsigned*)ST)[e] = 0u;
    f32x4 S0 = (f32x4){0.f, 0.f, 0.f, 0.f}, S1 = S0;
    float* og = (float*)(ws + WS_O) + hh * 128 + sl * 32 + vb * 16 + r; float* dump = (float*)(ws + WS_DUMP) + tid;
    const size_t ci0 = (size_t)bh * NCHUNK;
    GdnSet R0, R1, R2;
    gdn_issue(R0, ws, ci0 + 0, sl, tid); gdn_issue(R1, ws, ci0 + 1, sl, tid); gdn_issue(R2, ws, ci0 + 2, sl, tid);
    gdn_put(R0, lds, tid); float gt_cur = R0.gt;
    __syncthreads();
    auto step = [&](int n, GdnSet& fr, GdnSet& nx) {
        if (!(ABL & 1)) gdn_issue(fr, ws, ci0 + (n + 3 < NCHUNK ? n + 3 : NCHUNK - 1), sl, tid);
        const LAS unsigned char* slot = lds + (n & 1) * GS_SLOT;
        if (!(ABL & 2)) gdn_put(nx, lds + ((n + 1) & 1) * GS_SLOT, tid);
        const float gt_next = nx.gt;
        const u32x2 uu = *(const LAS u32x2*)(slot + GS_U + (vb * 16 + r) * 144 + (ib * 16 + 4 * q) * 2);
        f32x4 vn = (f32x4){bflo(uu.x), bfhi(uu.x), bflo(uu.y), bfhi(uu.y)}, oo = (f32x4){0.f, 0.f, 0.f, 0.f};
        const LAS bf16* sp = ST + (vb * 16 + r) * LDS_K + 8 * q;
        const LAS unsigned char* wp = slot + GS_W + (ib * 16 + r) * 272 + 16 * q; const LAS unsigned char* qp = slot + GS_QD + (ib * 16 + r) * 272 + 16 * q;
#pragma unroll
        for (int s = 0; s < 4; ++s) { const gbf16x8 bs = *(const LAS gbf16x8*)(sp + 32 * s);
            vn = __builtin_amdgcn_mfma_f32_16x16x32_bf16(*(const LAS gbf16x8*)(wp + 64 * s), bs, vn, 0, 0, 0); oo = __builtin_amdgcn_mfma_f32_16x16x32_bf16(*(const LAS gbf16x8*)(qp + 64 * s), bs, oo, 0, 0, 0); }
        { u32x2 pk; pk.x = pk2(vn[0], vn[1]); pk.y = pk2(vn[2], vn[3]); *(LAS u32x2*)(VNT + (vb * 16 + r) * LDS_I + ib * 16 + 4 * q) = pk; }
        LBAR();
        S0 = S0 * gt_cur; S1 = S1 * gt_cur;
        const LAS unsigned char* ap = slot + GS_AT + (ib * 16 + r) * 144 + 16 * q; const LAS unsigned char* kp = slot + GS_KD + (kb * 16 + r) * 144 + 16 * q;
#pragma unroll
        for (int s = 0; s < 2; ++s) { const gbf16x8 b0 = *(const LAS gbf16x8*)(VNT + r * LDS_I + 32 * s + 8 * q), b1 = *(const LAS gbf16x8*)(VNT + (16 + r) * LDS_I + 32 * s + 8 * q);
            const gbf16x8 ka = *(const LAS gbf16x8*)(kp + 64 * s);
            oo = __builtin_amdgcn_mfma_f32_16x16x32_bf16(*(const LAS gbf16x8*)(ap + 64 * s), vb ? b1 : b0, oo, 0, 0, 0);
            S0 = __builtin_amdgcn_mfma_f32_16x16x32_bf16(ka, b0, S0, 0, 0, 0); S1 = __builtin_amdgcn_mfma_f32_16x16x32_bf16(ka, b1, S1, 0, 0, 0); }
        { u32x2 pk; pk.x = pk2(S0[0], S0[1]); pk.y = pk2(S0[2], S0[3]); *(LAS u32x2*)(ST + r * LDS_K + kb * 16 + 4 * q) = pk;
          pk.x = pk2(S1[0], S1[1]); pk.y = pk2(S1[2], S1[3]); *(LAS u32x2*)(ST + (16 + r) * LDS_K + kb * 16 + 4 * q) = pk; }
#pragma unroll
        for (int e = 0; e < 4; ++e) { const int t = 64 * n - 48 + ib * 16 + 4 * q + e; float* dst = t >= 0 ? og + ((size_t)b * TP + t) * 1024 : dump; if (!(ABL & 4)) *dst = oo[e]; else if (oo[e] == 1.2345e33f) *dst = 0.f; }
        gt_cur = gt_next;
        LBAR();
    };
    static_assert(NCHUNK % 3 == 0, "129 chunks = 43 x 3");
    constexpr int NW1 = PREP_SPLIT - 3;
    static_assert(NW1 % 3 == 0 && NW1 > 0, "the wait sits between two unrolled trips");
    for (int n = 0; n < (LATE ? NW1 : NCHUNK); n += 3) { step(n, R0, R1); step(n + 1, R1, R2); step(n + 2, R2, R0); }
    if (LATE) {
        if (tid == 0) { unsigned sp = 0; const unsigned want = gridDim.x - 64;
            while (__hip_atomic_load((unsigned*)(ws + WS_FLAG), __ATOMIC_RELAXED, __HIP_MEMORY_SCOPE_AGENT) < want) { __builtin_amdgcn_s_sleep(2); if (++sp > (1u << 22)) break; } }
        __syncthreads();
        __builtin_amdgcn_fence(__ATOMIC_ACQUIRE, "agent"); asm volatile("s_waitcnt vmcnt(0)" ::: "memory");
        for (int n = NW1; n < NCHUNK; n += 3) { step(n, R0, R1); step(n + 1, R1, R2); step(n + 2, R2, R0); }
    }
}

typedef short lbf16x8 __attribute__((ext_vector_type(8)));
struct LruPre { u32x4 z[8]; };
__device__ __forceinline__ void lru_issue(const Params& p, int item, LruPre& P) {
    const int tid = threadIdx.x; const int blk = item & 7, bn = item >> 3, b = bn / NCHUNK, n = bn - b * NCHUNK;
    const bf16* z = (const bf16*)(p.ws + WS_Z); const int ch0 = blk * 128 + (tid & 15) * 8;
#pragma unroll
    for (int h = 0; h < 2; ++h) { const int i = (tid >> 4) + 32 * h, t = 64 * n - 48 + i;
#pragma unroll
        for (int j = 0; j < 4; ++j) { const int ts = t - 3 + j; P.z[h * 4 + j] = (u32x4){0u, 0u, 0u, 0u}; if (ts >= 0) P.z[h * 4 + j] = *(const u32x4*)(z + ((size_t)b * TP + ts) * LDZ1 + 4096 + ch0); } }
}
__device__ __forceinline__ void lru_item(const Params& p, LAS unsigned char* lds, int item, LruPre& P, int next) {
    const int tid = threadIdx.x, lane = tid & 63, wave = __builtin_amdgcn_readfirstlane(tid >> 6);
    const int blk = item & 7, bn = item >> 3, b = bn / NCHUNK, n = bn - b * NCHUNK;
    unsigned char* ws = p.ws; const bf16* z = (const bf16*)(ws + WS_Z);
    constexpr int LD = 129, LB = 136;
    LAS float* Xf = (LAS float*)lds; LAS bf16* Xb = (LAS bf16*)(lds + 33024); LAS float* Af = (LAS float*)(lds + 50432); LAS float* Bf = (LAS float*)(lds + 83456);
    LAS float* Pq = (LAS float*)(lds + 116480); LAS float* Hq = Pq + 512;
    LAS bf16* HLb = (LAS bf16*)lds; LAS bf16* PPb = HLb + 64 * 128;
    const int r = lane & 15, q = lane >> 4, ob = wave;
    lbf16x8 br[4], bi[4];
    { const bf16* wr = (const bf16*)(ws + WS_LRUW) + (size_t)blk * 16384 + (ob * 16 + r) * 128 + 8 * q; const bf16* wi = wr + 8 * 16384;
#pragma unroll
      for (int s = 0; s < 4; ++s) { br[s] = *(const lbf16x8*)(wr + 32 * s); bi[s] = *(const lbf16x8*)(wi + 32 * s); } }
    { const int cg = tid & 15, ch0 = blk * 128 + cg * 8; const float* cw = p.in[17]; const float* cb = p.in[18];
      f32x4 wa[4], wb[4];
#pragma unroll
      for (int j = 0; j < 4; ++j) { wa[j] = *(const f32x4*)(cw + j * 1024 + ch0); wb[j] = *(const f32x4*)(cw + j * 1024 + ch0 + 4); }
      const f32x4 ba = *(const f32x4*)(cb + ch0), bb = *(const f32x4*)(cb + ch0 + 4);
#pragma unroll
      for (int h = 0; h < 2; ++h) { const int i = (tid >> 4) + 32 * h, t = 64 * n - 48 + i; float x[8];
#pragma unroll
          for (int e = 0; e < 8; ++e) x[e] = 0.f;
          if (t >= 0) {
#pragma unroll
              for (int e = 0; e < 4; ++e) { x[e] = ba[e]; x[4 + e] = bb[e]; }
#pragma unroll
              for (int j = 0; j < 4; ++j) { const int ts = t - 3 + j;
                  if (ts >= 0) { const u32x4 zz = P.z[h * 4 + j];
                      x[0] += wa[j][0] * bflo(zz.x); x[1] += wa[j][1] * bfhi(zz.x); x[2] += wa[j][2] * bflo(zz.y); x[3] += wa[j][3] * bfhi(zz.y);
                      x[4] += wb[j][0] * bflo(zz.z); x[5] += wb[j][1] * bfhi(zz.z); x[6] += wb[j][2] * bflo(zz.w); x[7] += wb[j][3] * bfhi(zz.w); } } }
#pragma unroll
          for (int e = 0; e < 8; ++e) Xf[i * LD + cg * 8 + e] = x[e];
          u32x4 w; w.x = pk2(x[0], x[1]); w.y = pk2(x[2], x[3]); w.z = pk2(x[4], x[5]); w.w = pk2(x[6], x[7]); *(LAS u32x4*)(Xb + i * LB + cg * 8) = w; } }
    if (next >= 0) lru_issue(p, next, P);
    LBAR();
    { const int ch = blk * 128 + ob * 16 + r; const float brg = p.in[20][ch], big = p.in[22][ch], spl = softplusf_(-p.in[23][ch]);
#pragma unroll
      for (int ib = 0; ib < 4; ++ib) { f32x4 ar = (f32x4){0.f, 0.f, 0.f, 0.f}, ai = ar;
#pragma unroll
          for (int s = 0; s < 4; ++s) { const lbf16x8 ax = *(const LAS lbf16x8*)(Xb + (ib * 16 + r) * LB + 32 * s + 8 * q);
              ar = __builtin_amdgcn_mfma_f32_16x16x32_bf16(ax, br[s], ar, 0, 0, 0); ai = __builtin_amdgcn_mfma_f32_16x16x32_bf16(ax, bi[s], ai, 0, 0, 0); }
#pragma unroll
          for (int e = 0; e < 4; ++e) { const int i = ib * 16 + 4 * q + e, t = 64 * n - 48 + i, o = ob * 16 + r;
              const float rg = sigmoidf_(ar[e] + brg), ig = sigmoidf_(ai[e] + big), x = Xf[i * LD + o];
              const float log_a = -8.0f * spl * rg; const float a = __expf(log_a), bq = __builtin_amdgcn_sqrtf(fmaxf(1.0f - a * a, 0.f)) * (ig * x);
              Af[i * LD + o] = t >= 0 ? a : 1.0f; Bf[i * LD + o] = t >= 0 ? bq : 0.f; } } }
    LBAR();
    { const int c = tid & 127, qq = tid >> 7; float hl = 0.f, pp = 1.0f;
#pragma unroll
      for (int k = 0; k < 16; ++k) { const int i = qq * 16 + k; const float a = Af[i * LD + c]; hl = a * hl + Bf[i * LD + c]; pp *= a; Af[i * LD + c] = pp; Bf[i * LD + c] = hl; }
      Pq[qq * 128 + c] = pp; Hq[qq * 128 + c] = hl;
      LBAR();
      float cin = 0.f, pin = 1.0f;
#pragma unroll
      for (int k = 0; k < 3; ++k) if (k < qq) { const float pk = Pq[k * 128 + c]; cin = pk * cin + Hq[k * 128 + c]; pin *= pk; }
#pragma unroll
      for (int k = 0; k < 16; ++k) { const int i = qq * 16 + k; const float pl = Af[i * LD + c]; const float hf = Bf[i * LD + c] + pl * cin, pf = pl * pin;
          HLb[i * 128 + c] = (bf16)f2bf(hf); PPb[i * 128 + c] = (bf16)f2bf(pf);
          if (i == 63) { const int ch = blk * 128 + c; ((float*)(ws + WS_LRUA))[((size_t)b * NCHUNK + n) * 1024 + ch] = pf; ((float*)(ws + WS_LRUB))[((size_t)b * NCHUNK + n) * 1024 + ch] = hf; } } }
    LBAR();
    { bf16* hlg = (bf16*)(ws + WS_HL); bf16* ppg = (bf16*)(ws + WS_PP);
#pragma unroll
      for (int k = 0; k < 2; ++k) { const int e = tid + NTHR * k, i = e >> 4, c8 = (e & 15) * 8, t = 64 * n - 48 + i;
          if (t >= 0) { const size_t o = ((size_t)b * TP + t) * 1024 + blk * 128 + c8; *(u32x4*)(hlg + o) = *(const LAS u32x4*)(HLb + i * 128 + c8); *(u32x4*)(ppg + o) = *(const LAS u32x4*)(PPb + i * 128 + c8); } } }
    LBAR();
}
__device__ __forceinline__ void lru_carry(const Params& p, int gi) {
    const int b = gi >> 10, ch = gi & 1023; unsigned char* ws = p.ws; float carry = 0.f;
    const float* A = (const float*)(ws + WS_LRUA) + (size_t)b * NCHUNK * 1024 + ch; const float* B = (const float*)(ws + WS_LRUB) + (size_t)b * NCHUNK * 1024 + ch; float* C = (float*)(ws + WS_LRUC) + (size_t)b * NCHUNK * 1024 + ch;
    for (int n0 = 0; n0 < NCHUNK; n0 += 8) { float a[8], bq[8];
#pragma unroll
        for (int k = 0; k < 8; ++k) { const int n = n0 + k < NCHUNK ? n0 + k : NCHUNK - 1; a[k] = A[(size_t)n * 1024]; bq[k] = B[(size_t)n * 1024]; }
#pragma unroll
        for (int k = 0; k < 8; ++k) if (n0 + k < NCHUNK) { C[(size_t)(n0 + k) * 1024] = carry; carry = a[k] * carry + bq[k]; } }
}

__device__ __forceinline__ void mix1_finalize(const Params& p) {
    const int tid = threadIdx.x, lane = tid & 63, wave = __builtin_amdgcn_readfirstlane(tid >> 6);
    unsigned char* ws = p.ws; const bf16* z = (const bf16*)(ws + WS_Z); bf16* a2 = (bf16*)(ws + WS_A2);
    const float* og = (const float*)(ws + WS_O); const bf16* hlg = (const bf16*)(ws + WS_HL); const bf16* ppg = (const bf16*)(ws + WS_PP);
    const float* ong = p.in[16];
    const int gw = blockIdx.x * NWAVES + wave, NGW = gridDim.x * NWAVES;
    for (int tok = gw; tok < NTOK; tok += NGW) {
        const int b = tok / T, t = tok - b * T; const size_t row = (size_t)b * TP + t; const int n = (t + 48) >> 6;
#pragma unroll
        for (int hh = 0; hh < 8; ++hh) { const int col = hh * 128 + 2 * lane;
            const f32x2 o = *(const f32x2*)(og + row * 1024 + col); const float ss = wave_sum(o.x * o.x + o.y * o.y);
            const float rstd = rsqrtf(ss * (1.0f / 128.0f) + EPS); const unsigned zc = *(const unsigned*)(z + row * LDZ1 + 3072 + col);
            const f32x2 g = *(const f32x2*)(ong + 2 * lane);
            *(unsigned*)(a2 + row * DM + col) = pk2(o.x * rstd * g.x * siluf_(bflo(zc)), o.y * rstd * g.y * siluf_(bfhi(zc))); }
        const float* car = (const float*)(ws + WS_LRUC) + ((size_t)b * NCHUNK + n) * 1024;
#pragma unroll
        for (int j = 0; j < 8; ++j) { const int ch = 2 * lane + 128 * j;
            const unsigned hl = *(const unsigned*)(hlg + row * 1024 + ch), pp = *(const unsigned*)(ppg + row * 1024 + ch), gd = *(const unsigned*)(z + row * LDZ1 + 5120 + ch);
            const f32x2 c = *(const f32x2*)(car + ch);
            *(unsigned*)(a2 + row * DM + 1024 + ch) = pk2((bflo(hl) + bflo(pp) * c.x) * geluf_tanh(bflo(gd)), (bfhi(hl) + bfhi(pp) * c.y) * geluf_tanh(bfhi(gd))); }
    }
}

typedef short tbf16x8 __attribute__((ext_vector_type(8)));
template <int KIND> __device__ __forceinline__ void tail_gemm(const Params& p, const bf16* A, const bf16* Bt) {
    const int tid = threadIdx.x, lane = tid & 63, wave = __builtin_amdgcn_readfirstlane(tid >> 6), r = lane & 15, q = lane >> 4;
    const int gw = wave * gridDim.x + blockIdx.x, NGW = gridDim.x * NWAVES;
    unsigned char* ws = p.ws;
    constexpr int NPLAIN = KIND == 0 ? 3072 / 16 : KIND == 1 ? 6144 / 16 : 2048 / 16, NGLU = KIND == 0 ? 64 : 0;
    for (int tix = gw; tix < 2 * NPLAIN; tix += NGW) {
        const int rb = tix & 1, ct = tix >> 1, colA = ct * 16; const size_t row0 = (size_t)rb * TP + 8192;
        const bf16* ap = A + (row0 + r) * DM + 8 * q; const bf16* bp = Bt + (size_t)(colA + r) * DM + 8 * q;
        f32x4 acc = (f32x4){0.f, 0.f, 0.f, 0.f};
#pragma unroll 1
        for (int s0 = 0; s0 < 64; s0 += 16) { tbf16x8 af[16], bf[16];
#pragma unroll
            for (int s = 0; s < 16; ++s) { af[s] = *(const tbf16x8*)(ap + 32 * (s0 + s)); bf[s] = *(const tbf16x8*)(bp + 32 * (s0 + s)); }
#pragma unroll
            for (int s = 0; s < 16; ++s) acc = __builtin_amdgcn_mfma_f32_16x16x32_bf16(af[s], bf[s], acc, 0, 0, 0); }
#pragma unroll
        for (int e = 0; e < 4; ++e) { const size_t row = row0 + 4 * q + e;
            if (KIND == 2) { bf16* hp = (bf16*)(ws + WS_H) + row * DM + colA + r; *hp = (bf16)f2bf(bf2f(*hp) + acc[e]); }
            else if (KIND == 1) ((bf16*)(ws + WS_Z))[row * LDZ1 + colA + r] = (bf16)f2bf(acc[e]);
            else ((bf16*)(ws + WS_Z))[row * LDZ0 + colA + r] = (bf16)f2bf(acc[e]); }
    }
    if (KIND == 0) for (int tix = gw; tix < 2 * NGLU; tix += NGW) {
        const int rb = tix & 1, g = tix >> 1, pt = g >> 3, cb = g & 7, colA = 3072 + pt * 256 + cb * 16; const size_t row0 = (size_t)rb * TP + 8192;
        const bf16* ap = A + (row0 + r) * DM + 8 * q; const bf16* bp = Bt + (size_t)(colA + r) * DM + 8 * q; const bf16* bp2 = bp + (size_t)128 * DM;
        f32x4 acc = (f32x4){0.f, 0.f, 0.f, 0.f}, acc2 = acc;
#pragma unroll 1
        for (int s0 = 0; s0 < 64; s0 += 8) { tbf16x8 af[8], bf[8], bg[8];
#pragma unroll
            for (int s = 0; s < 8; ++s) { af[s] = *(const tbf16x8*)(ap + 32 * (s0 + s)); bf[s] = *(const tbf16x8*)(bp + 32 * (s0 + s)); bg[s] = *(const tbf16x8*)(bp2 + 32 * (s0 + s)); }
#pragma unroll
            for (int s = 0; s < 8; ++s) { acc = __builtin_amdgcn_mfma_f32_16x16x32_bf16(af[s], bf[s], acc, 0, 0, 0); acc2 = __builtin_amdgcn_mfma_f32_16x16x32_bf16(af[s], bg[s], acc2, 0, 0, 0); } }
#pragma unroll
        for (int e = 0; e < 4; ++e) { const size_t row = row0 + 4 * q + e;
            ((bf16*)(ws + WS_U))[row * 1024 + pt * 128 + cb * 16 + r] = (bf16)f2bf(acc[e] * __builtin_amdgcn_rcpf(1.0f + __expf(-acc2[e]))); }
    }
}

enum { PH_PRO = 0, PH_IN0, PH_CONV0, PH_MIX0, PH_OUT0, PH_FA0, PH_FB0, PH_FC0, PH_FD0, PH_NORM1, PH_IN1, PH_MIX1A, PH_MIX1B, PH_CARRY, PH_MIX1C, PH_OUT1, PH_FA1, PH_FB1, PH_FC1, PH_FD1, PH_FINAL, NPH };

#define XB_TMO      128
#define XB_XCNT(j)  (256  + 64 * (j))
#define XB_XSUB(j)  (1280 + 64 * (j))
#define XB_XGEN(j)  (2304 + 64 * (j))
#define XB_TOP      3328
#define XB_TOPGEN   3392
#define XCD_BAR_WORDS 3456
#define XB_SPIN_CAP (1u << 18)

__device__ __forceinline__ unsigned xb_ld(unsigned* p)              { return __hip_atomic_load(p, __ATOMIC_RELAXED, __HIP_MEMORY_SCOPE_AGENT); }
__device__ __forceinline__ unsigned xb_add(unsigned* p, unsigned v) { return __hip_atomic_fetch_add(p, v, __ATOMIC_RELAXED, __HIP_MEMORY_SCOPE_AGENT); }
__device__ __forceinline__ unsigned xb_xcc_id() { return (unsigned)__builtin_amdgcn_s_getreg((3 << 11) | 20) & 0xFu; }
#define XB_SPIN(cond, bar) do { unsigned _sp = 0; while (cond) { __builtin_amdgcn_s_sleep(1); \
    if ((++_sp & 255u) == 0u) { if (xb_ld(&(bar)[XB_TMO])) break; if (_sp > XB_SPIN_CAP) { atomicAdd(&(bar)[XB_TMO], 1u); break; } } } } while (0)

struct XcdBarrier {
    unsigned* bar; unsigned x;
    volatile LAS unsigned* st;
};

__device__ __forceinline__ XcdBarrier xcd_barrier_post(unsigned* bar, volatile LAS unsigned* st) {
    XcdBarrier b; b.bar = bar; b.x = xb_xcc_id(); b.st = st;
    if (threadIdx.x == 0) (void)xb_add(&bar[XB_XCNT(b.x)], 1u);
    return b;
}
__device__ __forceinline__ void xcd_barrier_complete(unsigned* bar, unsigned x, unsigned& nloc, unsigned& nx) {
    const unsigned G = gridDim.x * gridDim.y * gridDim.z;
    unsigned sum, cnt, mine, sp = 0u;
    for (;;) {
        sum = 0u; cnt = 0u; mine = 0u;
#pragma unroll
        for (unsigned j = 0; j < 16; ++j) { const unsigned c = xb_ld(&bar[XB_XCNT(j)]); sum += c; cnt += (c > 0u) ? 1u : 0u; mine = (j == x) ? c : mine; }
        if (sum == G) break;
        __builtin_amdgcn_s_sleep(1);
        if ((++sp & 255u) == 0u) { if (xb_ld(&bar[XB_TMO])) break; if (sp > XB_SPIN_CAP) { atomicAdd(&bar[XB_TMO], 1u); break; } }
    }
    nloc = mine > 0u ? mine : 1u; nx = cnt > 0u ? cnt : 1u;
}

__device__ __forceinline__ void xcd_barrier(const XcdBarrier& b) {
    asm volatile("s_waitcnt vmcnt(0)" ::: "memory");
    __syncthreads();
    if (threadIdx.x == 0) {
        unsigned* bar = b.bar;
        __builtin_amdgcn_s_waitcnt(0);
        unsigned nloc = b.st[0], nx = b.st[1];
        if (nloc == 0u) { xcd_barrier_complete(bar, b.x, nloc, nx); b.st[0] = nloc; b.st[1] = nx; }
        const unsigned old = xb_add(&bar[XB_XSUB(b.x)], 1u);
        const unsigned gen = old / nloc;
        if (old + 1u == (gen + 1u) * nloc) {
            __builtin_amdgcn_fence(__ATOMIC_RELEASE, "agent");
            asm volatile("s_waitcnt vmcnt(0)" ::: "memory");
            const unsigned og = xb_add(&bar[XB_TOP], 1u);
            const unsigned tg = og / nx;
            if (og + 1u == (tg + 1u) * nx) xb_add(&bar[XB_TOPGEN], 1u);
            else XB_SPIN(xb_ld(&bar[XB_TOPGEN]) == tg, bar);
            __builtin_amdgcn_fence(__ATOMIC_ACQUIRE, "agent");
            xb_add(&bar[XB_XGEN(b.x)], 1u);
            asm volatile("s_waitcnt vmcnt(0)" ::: "memory");
        } else {
            XB_SPIN(xb_ld(&bar[XB_XGEN(b.x)]) == gen, bar);
            __builtin_amdgcn_fence(__ATOMIC_ACQUIRE, "agent");
            asm volatile("s_waitcnt vmcnt(0)" ::: "memory");
        }
    }
    __syncthreads();
}

template <int PH> __device__ __forceinline__ void run_phase(const Params& p0, LAS unsigned char* lds) {
    const Params& p = p0;
    unsigned char* ws = p.ws;
#define TIDS const int tid = threadIdx.x, lane = tid & 63, wave = __builtin_amdgcn_readfirstlane(tid >> 6); const int gw = blockIdx.x * NWAVES + wave, NGW = gridDim.x * NWAVES, gtid = blockIdx.x * NTHR + tid, GT = gridDim.x * NTHR; (void)lane; (void)gw; (void)NGW; (void)gtid; (void)GT
    if constexpr (PH == PH_PRO) { TIDS;
        if (gtid < 2048) ((unsigned*)(ws + WS_CTL))[gtid] = 0u;
        convert_weights(p, lds, 0, N_DENSE_ITEMS);
        conv_extras(p, gtid, GT);
        for (int i = gtid; i < 2 * (TP - T) * (DM / 8); i += GT) { const int r = i / (DM / 8), c = i - r * (DM / 8), b = r / (TP - T), t = T + r - b * (TP - T); const size_t o = ((size_t)b * TP + t) * DM + c * 8;
            *(u32x4*)((bf16*)(ws + WS_HN) + o) = (u32x4){0u, 0u, 0u, 0u}; *(u32x4*)((bf16*)(ws + WS_A2) + o) = (u32x4){0u, 0u, 0u, 0u}; }
        for (int i = gtid; i < 16 * (TP - T); i += GT) { const int bh = i / (TP - T), t = T + i - bh * (TP - T); ((float*)(ws + WS_LOGF))[(size_t)bh * TP + t] = 0.f; }
        for (int i = gtid; i < 2 * (TP - T) * (LDZ0 / 8); i += GT) { const int r = i / (LDZ0 / 8), c = i - r * (LDZ0 / 8), b = r / (TP - T), t = T + r - b * (TP - T);
            *(u32x4*)((bf16*)(ws + WS_Z) + ((size_t)b * TP + t) * LDZ0 + c * 8) = (u32x4){0u, 0u, 0u, 0u}; }
        __syncthreads(); norm_phase<0>(p, lds, 0);
    }
    if constexpr (PH == PH_IN0) {
        for (int bh = blockIdx.x; bh < 16; bh += gridDim.x) fox_cumsum(p, lds, bh);
        pg8::Gemm g{(const bf16*)(ws + WS_HN), (const bf16*)(ws + WS_W0IN), MROWS, 5120, DM}; pg8::Order64 S; S.init(64 * 256, 5120, gridDim.x, blockIdx.x);
        pg8::EpiIn0 E{(bf16*)(ws + WS_Z), (bf16*)(ws + WS_U)};
        pg8::gemm_phase<pg8::EpiIn0, pg8::Order64, true, true>(lds, g, S, E);
        tail_gemm<0>(p, (const bf16*)(ws + WS_HN), (const bf16*)(ws + WS_W0IN));
    }
    if constexpr (PH == PH_MIX0) mix0_phase(p, lds);
    if constexpr (PH == PH_CONV0) conv_phase(p, lds);
    if constexpr (PH == PH_OUT0 || PH == PH_OUT1) { pg8::Gemm g{(const bf16*)(ws + WS_A2), (const bf16*)(ws + (PH == PH_OUT0 ? WS_W0OUT : WS_W1OUT)), MROWS, DM, DM}; pg8::Order64 S; S.init(64 * 256, DM, gridDim.x, blockIdx.x);
        pg8::EpiResid E{(bf16*)(ws + WS_H), DM}; pg8::gemm_phase<pg8::EpiResid, pg8::Order64, true, true>(lds, g, S, E);
        tail_gemm<2>(p, (const bf16*)(ws + WS_A2), (const bf16*)(ws + (PH == PH_OUT0 ? WS_W0OUT : WS_W1OUT))); }
    if constexpr (PH == PH_FA0 || PH == PH_FA1) norm_phase<1>(p, lds, PH == PH_FA0 ? 0 : 1);
    if constexpr (PH == PH_FB0 || PH == PH_FB1) moe_scatter_phase(p, lds);
    if constexpr (PH == PH_FC0 || PH == PH_FC1) { LAS int* tab = (LAS int*)(lds + MISC_OFF); moe_offsets((const unsigned*)(ws + WS_CTL), tab);
        pg8::Gemm g{(const bf16*)(ws + WS_HN), (const bf16*)(ws + WS_WGU), RMAX, NEXP * 1024, DM};
        pg8::MoeOrder S; S.NB = tab[64]; S.ncol = 4; S.nwg = S.NB * 4; S.G = gridDim.x; S.c = blockIdx.x; S.blk_e = tab + 65;
        pg8::EpiSwiGLU E{(bf16*)(ws + WS_HID)}; pg8::gemm_phase_gather<pg8::EpiSwiGLU, pg8::MoeOrder>(lds, g, S, E, (const int*)(ws + WS_ROWTOK)); }
    if constexpr (PH == PH_FD0 || PH == PH_FD1) { LAS int* tab = (LAS int*)(lds + MISC_OFF); moe_offsets((const unsigned*)(ws + WS_CTL), tab);
        pg8::Gemm g{(const bf16*)(ws + WS_HID), (const bf16*)(ws + WS_WD), RMAX, NEXP * 2048, DEXP};
        pg8::MoeOrder S; S.NB = tab[64]; S.ncol = 8; S.nwg = S.NB * 8; S.G = gridDim.x; S.c = blockIdx.x; S.blk_e = tab + 65;
        pg8::EpiDown E{(bf16*)(ws + WS_XS)}; pg8::gemm_phase<pg8::EpiDown, pg8::MoeOrder, true, true>(lds, g, S, E); }
    if constexpr (PH == PH_NORM1) { TIDS;
        if (gtid < 2048) ((unsigned*)(ws + WS_CTL))[gtid] = 0u;
        convert_weights(p, lds, 1, 0);
        __syncthreads();
        norm_phase<2>(p, lds, 1);
    }
    if constexpr (PH == PH_IN1) {
        pg8::Gemm g{(const bf16*)(ws + WS_HN), (const bf16*)(ws + WS_W1IN), MROWS, LDZ1, DM}; pg8::Order64 S; S.init(64 * 256, LDZ1, gridDim.x, blockIdx.x);
        pg8::EpiBf16<0> E{(bf16*)(ws + WS_Z), LDZ1, nullptr, 0, 0, 1.f};
        pg8::gemm_phase<pg8::EpiBf16<0>, pg8::Order64, true, true>(lds, g, S, E);
        tail_gemm<1>(p, (const bf16*)(ws + WS_HN), (const bf16*)(ws + WS_W1IN));
    }
    if constexpr (PH == PH_MIX1A) {
        { const int wend = (gridDim.x > 68 ? PREP_SPLIT : NCHUNK) * 16; PrepPre P; int w = blockIdx.x; if (w < wend) gdn_prep_issue(p, PREP_ITEM(w), P);
          for (; w < wend; w += gridDim.x) { const int wn = w + gridDim.x; gdn_prep_item(p, lds, PREP_ITEM(w), P, wn < wend ? PREP_ITEM(wn) : NCH); } }
    }
    if constexpr (PH == PH_MIX1B) {
        const int G = gridDim.x, first = G > 68 ? 64 : 0;
        if ((int)blockIdx.x < 64 || first == 0) for (int it = blockIdx.x; it < 64; it += gridDim.x) { if (first) gdn_scan_item<0, true>(p, lds, it); else gdn_scan_item<0, false>(p, lds, it); }
        if ((int)blockIdx.x >= first) {
            if (first) {
                const int nb = G - first, wend = NCHUNK * 16; PrepPre P; int w = PREP_SPLIT * 16 + (int)blockIdx.x - first; if (w < wend) gdn_prep_issue(p, PREP_ITEM(w), P);
                for (; w < wend; w += nb) { const int wn = w + nb; gdn_prep_item(p, lds, PREP_ITEM(w), P, wn < wend ? PREP_ITEM(wn) : NCH); }
                asm volatile("s_waitcnt vmcnt(0)" ::: "memory"); __syncthreads();
                if (threadIdx.x == 0) { __builtin_amdgcn_fence(__ATOMIC_RELEASE, "agent"); asm volatile("s_waitcnt vmcnt(0)" ::: "memory");
                    __hip_atomic_fetch_add((unsigned*)(ws + WS_FLAG), 1u, __ATOMIC_RELAXED, __HIP_MEMORY_SCOPE_AGENT); }
                __syncthreads();
            }
            { constexpr int NL = 2 * NCHUNK * 8; const int st = G - first; LruPre LP; int it = (int)blockIdx.x - first; if (it < NL) lru_issue(p, it, LP);
              for (; it < NL; it += st) lru_item(p, lds, it, LP, it + st < NL ? it + st : -1); }
        }
    }
    if constexpr (PH == PH_CARRY) { const int tid = threadIdx.x; for (int gi = blockIdx.x * NTHR + tid; gi < 2048; gi += gridDim.x * NTHR) lru_carry(p, gi); }
    if constexpr (PH == PH_MIX1C) mix1_finalize(p);
    if constexpr (PH == NPH + 1) { PrepPre P; int it = blockIdx.x; if (it < NCH) gdn_prep_issue(p, it, P);
          for (; it < NCH; it += gridDim.x) gdn_prep_item(p, lds, it, P, it + gridDim.x); }
    if constexpr (PH == NPH + 13 || PH == NPH + 14 || PH == NPH + 15 || PH == NPH + 16 || PH == NPH + 17 || PH == NPH + 18 || PH == NPH + 19) { constexpr int AB = PH == NPH + 13 ? 1 : PH == NPH + 14 ? 2 : PH == NPH + 15 ? 4 : PH == NPH + 17 ? 8 : PH == NPH + 18 ? 16 : PH == NPH + 19 ? 32 : 7; PrepPre P; int it = blockIdx.x; if (it < NCH) gdn_prep_issue(p, it, P);
          for (; it < NCH; it += gridDim.x) gdn_prep_item<AB>(p, lds, it, P, it + gridDim.x); }
    if constexpr (PH == NPH + 2) { constexpr int NL = 2 * NCHUNK * 8; LruPre LP; int it = blockIdx.x; if (it < NL) lru_issue(p, it, LP); for (; it < NL; it += gridDim.x) lru_item(p, lds, it, LP, it + (int)gridDim.x < NL ? it + (int)gridDim.x : -1); }
    if constexpr (PH == NPH + 3) for (int it = blockIdx.x; it < 64; it += gridDim.x) gdn_scan_item(p, lds, it);
    if constexpr (PH == NPH + 5) for (int it = blockIdx.x; it < 64; it += gridDim.x) gdn_scan_item<1>(p, lds, it);
    if constexpr (PH == NPH + 6) for (int it = blockIdx.x; it < 64; it += gridDim.x) gdn_scan_item<3>(p, lds, it);
    if constexpr (PH == NPH + 7) for (int it = blockIdx.x; it < 64; it += gridDim.x) gdn_scan_item<7>(p, lds, it);
    if constexpr (PH == NPH + 4) convert_weights(p, lds, 1, 0);
    if constexpr (PH == NPH + 20 || PH == NPH + 21 || PH == NPH + 22) {
        pg8::Gemm g{(const bf16*)(ws + WS_HN), (const bf16*)(ws + WS_W1IN), MROWS, LDZ1, DM}; pg8::Order64 S; S.init(64 * 256, LDZ1, gridDim.x, blockIdx.x);
        pg8::EpiBf16<0> E{(bf16*)(ws + WS_Z), LDZ1, nullptr, 0, 0, 1.f};
        if constexpr (PH == NPH + 20) pg8::gemm_phase<pg8::EpiBf16<0>, pg8::Order64, true, true>(lds, g, S, E);
        if constexpr (PH == NPH + 21) pg8::gemm_phase<pg8::EpiBf16<0>, pg8::Order64, true, false>(lds, g, S, E);
        if constexpr (PH == NPH + 22) pg8::gemm_phase<pg8::EpiBf16<0>, pg8::Order64, false, true>(lds, g, S, E); }
    if constexpr (PH == NPH + 11) convert_weights(p, lds, 0, N_DENSE_ITEMS);
    if constexpr (PH == NPH + 12) norm_phase<0>(p, lds, 0);
    if constexpr (PH == NPH + 8) norm_phase<3, 1>(p, lds, 0);
    if constexpr (PH == NPH + 9) norm_phase<3, 2>(p, lds, 0);
    if constexpr (PH == NPH + 10) norm_phase<3, 3>(p, lds, 0);
    if constexpr (PH == PH_FINAL) norm_phase<3>(p, lds, 0);
#undef TIDS
}

__global__ void __launch_bounds__(NTHR, 2) mk_fwd(Params p) {
    extern __shared__ __attribute__((aligned(16))) unsigned char lds_raw[];
    LAS unsigned char* lds = (LAS unsigned char*)lds_raw;
    cg::grid_group grid = cg::this_grid();
    const int lo = p.ph_lo, hi = p.ph_hi;
    volatile LAS unsigned* bst = (volatile LAS unsigned*)(lds + LDS_BYTES - 16);
    if (threadIdx.x < 2) bst[threadIdx.x] = 0u;
    __syncthreads();
    (void)xcd_barrier_post((unsigned*)(p.ws + WS_BAR), bst);
    if (hi < -12345) grid.sync();
#define XBAR() do { XcdBarrier b_; b_.bar = (unsigned*)(p.ws + WS_BAR); b_.x = xb_xcc_id(); b_.st = (volatile LAS unsigned*)(lds + LDS_BYTES - 16); xcd_barrier(b_); } while (0)
#define PHASE(k) do { if (lo <= (k) && (k) < hi) { run_phase<(k)>(p, lds); if ((k) + 1 < hi) XBAR(); } } while (0)
#define PHASE_NB(k) do { if (lo <= (k) && (k) < hi) { run_phase<(k)>(p, lds); asm volatile("s_waitcnt vmcnt(0) lgkmcnt(0)" ::: "memory"); __syncthreads(); } } while (0)
    PHASE(PH_PRO); PHASE(PH_IN0); PHASE_NB(PH_CONV0); PHASE(PH_MIX0); PHASE(PH_OUT0); PHASE(PH_FA0); PHASE(PH_FB0); PHASE(PH_FC0); PHASE(PH_FD0); PHASE(PH_NORM1);
    PHASE(PH_IN1); PHASE(PH_MIX1A); PHASE(PH_MIX1B); PHASE(PH_CARRY); PHASE(PH_MIX1C); PHASE(PH_OUT1); PHASE(PH_FA1); PHASE(PH_FB1); PHASE(PH_FC1); PHASE(PH_FD1); PHASE(PH_FINAL);
#if MK_EXTRA_PHASE >= 0
#pragma unroll 1
    for (int xr = 0; xr < MK_EXTRA_REPS; ++xr) { XBAR(); run_phase<MK_EXTRA_PHASE>(p, lds); }
#endif
#undef PHASE
}

extern "C" void kernel_launch(void* const* d_in, const int* in_sizes, int n_in, void* d_out, int out_size, void* d_ws, size_t ws_size, hipStream_t stream) {
    static int grid = 0;
    if (grid == 0) {
        if (n_in != 32 || ws_size < WS_END) { fprintf(stderr, "kernel_launch: expected 32 inputs and >= %zu bytes of workspace (got %d, %zu)\n", (size_t)WS_END, n_in, ws_size); grid = -1; return; }
        int dev = 0, cus = 0, per_cu = 0;
        hipGetDevice(&dev); hipDeviceGetAttribute(&cus, hipDeviceAttributeMultiprocessorCount, dev);
        if (hipFuncSetAttribute((const void*)mk_fwd, hipFuncAttributeMaxDynamicSharedMemorySize, LDS_BYTES) != hipSuccess) { fprintf(stderr, "kernel_launch: hipFuncSetAttribute failed\n"); grid = -1; return; }
        if (hipOccupancyMaxActiveBlocksPerMultiprocessor(&per_cu, (const void*)mk_fwd, NTHR, LDS_BYTES) != hipSuccess || per_cu < 1) { fprintf(stderr, "kernel_launch: occupancy query failed (%d)\n", per_cu); per_cu = 1; }
        (void)hipGetLastError();
        grid = cus * (per_cu > 1 ? 1 : per_cu);
        if (grid <= 0) grid = 256;
    }
    if (grid < 0) return;
    (void)hipMemsetAsync((char*)d_ws + WS_BAR, 0, 16 * 1024 + 256, stream);
    Params p{};
    for (int i = 0; i < 32; ++i) p.in[i] = (const float*)d_in[i];
    p.out = (float*)d_out; p.ws = (unsigned char*)d_ws;
#if MK_ONE_LAUNCH
    p.ph_lo = 0; p.ph_hi = NPH;
    void* args[] = {&p};
    hipError_t e = hipLaunchCooperativeKernel((const void*)mk_fwd, dim3(grid), dim3(NTHR), args, LDS_BYTES, stream);
    if (e != hipSuccess) fprintf(stderr, "cooperative launch failed: %s (grid %d)\n", hipGetErrorString(e), grid);
#else
    for (int ph = 0; ph < NPH && ph < MK_LAST_PHASE; ++ph) { p.ph_lo = ph; p.ph_hi = ph + 1; hipLaunchKernelGGL(mk_fwd, dim3(grid), dim3(NTHR), LDS_BYTES, stream, p); }
#endif
}
```

```cpp
#include <hip/hip_runtime.h>
#include <hip/hip_cooperative_groups.h>
#include <cstdio>
#include <cstdint>
namespace cg = cooperative_groups;
#define MK_ONE_LAUNCH 1
#define MK_LAST_PHASE 99
#define MK_EXTRA_PHASE -1
#define MK_EXTRA_REPS 1
namespace pg8 {
#define PG8_LAS __attribute__((address_space(3)))
typedef unsigned short bf16_t;
typedef short bf16x8 __attribute__((ext_vector_type(8)));
typedef float f32x4 __attribute__((ext_vector_type(4)));
typedef unsigned u32x4 __attribute__((ext_vector_type(4)));
constexpr int BM = 256, BK = 64, HALF = 128, HTB = HALF * BK * 2  , STAGE_BYTES = 8 * HTB, NXCD = 8, WGM = 4;

__host__ __device__ __forceinline__ int lds_byte(int r, int c) { const int st = (r >> 4) * 2 + (c >> 5), rr = r & 15, cc = c & 31, ob = rr * 64 + cc * 2; return st * 1024 + (ob ^ (((ob >> 9) & 1) << 5)); }
__host__ __device__ __forceinline__ void stage_rc(int b, int& R, int& C) { const int st = b / 1024, sb = b % 1024, swz = sb ^ (((sb >> 9) & 1) << 5); R = (st >> 1) * 16 + swz / 64; C = (st & 1) * 32 + (swz % 64) / 2; }
__host__ __device__ __forceinline__ int perm32(int rho) { const int n = rho >> 4, i = rho & 15; return 8 * (i >> 2) + 4 * n + (i & 3); }

struct Unit { int pm, pn; };
struct Gemm { const bf16_t* A; const bf16_t* Bt; int M, N, K; };

struct StaticOrder {
    int nM, nN, nwg, G, c;
    __host__ __device__ void init(int M, int N, int G_, int c_) { nM = M / BM; nN = N / BM; nwg = nM * nN; G = G_; c = c_; }
    __host__ __device__ bool next(int i, Unit& u) const {
        const long L = (long)i * G + c; if (L >= nwg) return false;
        int wgid = (int)L; { const int q = nwg / NXCD, r = nwg % NXCD, xcd = wgid % NXCD, off = wgid / NXCD; wgid = (xcd < r ? xcd * (q + 1) : r * (q + 1) + (xcd - r) * q) + off; }
        const int nig = WGM * nN, gid = wgid / nig, fm = gid * WGM, gsz = (nM - fm) < WGM ? (nM - fm) : WGM;
        u.pm = fm + ((wgid % nig) % gsz); u.pn = (wgid % nig) / gsz; return true;
    }
    __device__ __forceinline__ void a_ready(const Unit&) const {}
    __device__ __forceinline__ void done(const Unit&) const {}
};

__device__ __forceinline__ unsigned cvt_pk_bf16(float lo, float hi) { unsigned r; asm volatile("v_cvt_pk_bf16_f32 %0, %1, %2" : "=v"(r) : "v"(lo), "v"(hi)); return r; }
typedef float f32x2 __attribute__((ext_vector_type(2)));
__device__ __forceinline__ f32x2 gelu_pk(f32x2 v) {
    const f32x2 av = __builtin_elementwise_abs(v), d = av * 0.2316418882f + 1.0f;
    f32x2 t; t.x = __builtin_amdgcn_rcpf(d.x); t.y = __builtin_amdgcn_rcpf(d.y);
    f32x2 q = t * 0.5307027145f + (-0.7265760135f); q = q * t + 0.7107068705f; q = q * t + (-0.142248368f); q = q * t + 0.127414796f; q = q * t;
    const f32x2 s = (v * v) * (-0.72134752044f);
    f32x2 e; e.x = __builtin_amdgcn_exp2f(s.x); e.y = __builtin_amdgcn_exp2f(s.y);
    const f32x2 m = v * (q * e), r = v - m;
    f32x2 o; o.x = v.x < 0.f ? m.x : r.x; o.y = v.y < 0.f ? m.y : r.y; return o;
}

template <int ACT  > struct EpiBf16 {
    static constexpr bool PERM = true, AFTER_DRAIN = false; static_assert(ACT == 0 || ACT == 1, "EpiBf16: ACT is 0 (none) or 1 (gelu_pk)");
    bf16_t* O; int ldc; const float* bias; int split_cols; size_t split_stride; float scale0;
    __device__ __forceinline__ void operator()(const f32x4 (&acc)[2][2][4][2], const Unit& u, int wr, int wc, int fr, int fq) const {
        const int row0 = u.pm * BM + wr * 64 + fr; int colt = u.pn * BM; bf16_t* base = O;
        float sc = 1.f; if (split_cols) { const int t = colt / split_cols; base += (size_t)t * split_stride; colt -= t * split_cols; if (t == 0) sc = scale0; }
        const int col0 = colt + wc * 32 + 8 * fq, bcol0 = u.pn * BM + wc * 32 + 8 * fq;
        f32x4 bv[2][2];
#pragma unroll
        for (int bj = 0; bj < 2; ++bj)
#pragma unroll
            for (int n = 0; n < 2; ++n) bv[bj][n] = bias ? *(const f32x4*)(bias + bcol0 + bj * HALF + 4 * n) : (f32x4){0.f, 0.f, 0.f, 0.f};
#pragma unroll
        for (int ai = 0; ai < 2; ++ai)
#pragma unroll
            for (int m = 0; m < 4; ++m) { bf16_t* rowp = base + (size_t)(row0 + ai * HALF + m * 16) * ldc + col0;
#pragma unroll
                for (int bj = 0; bj < 2; ++bj) { f32x4 v0 = acc[ai][bj][m][0] + bv[bj][0], v1 = acc[ai][bj][m][1] + bv[bj][1];
                    if (ACT == 1) { f32x2 a = gelu_pk((f32x2){v0[0], v0[1]}), b = gelu_pk((f32x2){v0[2], v0[3]}), c = gelu_pk((f32x2){v1[0], v1[1]}), d = gelu_pk((f32x2){v1[2], v1[3]});
                        v0 = (f32x4){a.x, a.y, b.x, b.y}; v1 = (f32x4){c.x, c.y, d.x, d.y}; }
                    v0 = v0 * sc; v1 = v1 * sc; u32x4 w; w.x = cvt_pk_bf16(v0[0], v0[1]); w.y = cvt_pk_bf16(v0[2], v0[3]); w.z = cvt_pk_bf16(v1[0], v1[1]); w.w = cvt_pk_bf16(v1[2], v1[3]);
                    *(u32x4*)(rowp + bj * HALF) = w; } }
    }
};

struct EpiResid {
    static constexpr bool PERM = true, AFTER_DRAIN = false;
    bf16_t* C; int ldc;
    __device__ __forceinline__ void operator()(const f32x4 (&acc)[2][2][4][2], const Unit& u, int wr, int wc, int fr, int fq) const {
        const int row0 = u.pm * BM + wr * 64 + fr, col0 = u.pn * BM + wc * 32 + 8 * fq;
#pragma unroll
        for (int ai = 0; ai < 2; ++ai)
#pragma unroll
            for (int m = 0; m < 4; ++m) { bf16_t* rowp = C + (size_t)(row0 + ai * HALF + m * 16) * ldc + col0;
#pragma unroll
                for (int bj = 0; bj < 2; ++bj) { const u32x4 o = *(const u32x4*)(rowp + bj * HALF); const f32x4 v0 = acc[ai][bj][m][0], v1 = acc[ai][bj][m][1];
                    u32x4 w; w.x = cvt_pk_bf16(__builtin_bit_cast(float, o.x << 16) + v0[0], __builtin_bit_cast(float, o.x & 0xffff0000u) + v0[1]);
                    w.y = cvt_pk_bf16(__builtin_bit_cast(float, o.y << 16) + v0[2], __builtin_bit_cast(float, o.y & 0xffff0000u) + v0[3]);
                    w.z = cvt_pk_bf16(__builtin_bit_cast(float, o.z << 16) + v1[0], __builtin_bit_cast(float, o.z & 0xffff0000u) + v1[1]);
                    w.w = cvt_pk_bf16(__builtin_bit_cast(float, o.w << 16) + v1[2], __builtin_bit_cast(float, o.w & 0xffff0000u) + v1[3]);
                    *(u32x4*)(rowp + bj * HALF) = w; } }
    }
};
struct EpiIn0 {
    static constexpr bool PERM = true, AFTER_DRAIN = false;
    bf16_t* Z; bf16_t* U;
    __device__ __forceinline__ void operator()(const f32x4 (&acc)[2][2][4][2], const Unit& u, int wr, int wc, int fr, int fq) const {
        const int row0 = u.pm * BM + wr * 64 + fr;
        if (u.pn < 12) {
            const int col0 = u.pn * BM + wc * 32 + 8 * fq;
#pragma unroll
            for (int ai = 0; ai < 2; ++ai)
#pragma unroll
                for (int m = 0; m < 4; ++m) { bf16_t* rowp = Z + (size_t)(row0 + ai * HALF + m * 16) * 3072 + col0;
#pragma unroll
                    for (int bj = 0; bj < 2; ++bj) { const f32x4 v0 = acc[ai][bj][m][0], v1 = acc[ai][bj][m][1];
                        u32x4 w; w.x = cvt_pk_bf16(v0[0], v0[1]); w.y = cvt_pk_bf16(v0[2], v0[3]); w.z = cvt_pk_bf16(v1[0], v1[1]); w.w = cvt_pk_bf16(v1[2], v1[3]);
                        *(u32x4*)(rowp + bj * HALF) = w; } }
        } else {
            const int col0 = (u.pn - 12) * HALF + wc * 32 + 8 * fq;
#pragma unroll
            for (int ai = 0; ai < 2; ++ai)
#pragma unroll
                for (int m = 0; m < 4; ++m) { bf16_t* rowp = U + (size_t)(row0 + ai * HALF + m * 16) * 1024 + col0;
                    float h[8];
#pragma unroll
                    for (int n = 0; n < 2; ++n)
#pragma unroll
                        for (int j = 0; j < 4; ++j) { const float a = acc[ai][0][m][n][j], b = acc[ai][1][m][n][j]; h[4 * n + j] = a * __builtin_amdgcn_rcpf(1.0f + __expf(-b)); }
                    u32x4 w; w.x = cvt_pk_bf16(h[0], h[1]); w.y = cvt_pk_bf16(h[2], h[3]); w.z = cvt_pk_bf16(h[4], h[5]); w.w = cvt_pk_bf16(h[6], h[7]);
                    *(u32x4*)rowp = w; }
        }
    }
};
struct EpiSwiGLU {
    static constexpr bool PERM = true, AFTER_DRAIN = false;
    bf16_t* O;
    __device__ __forceinline__ void operator()(const f32x4 (&acc)[2][2][4][2], const Unit& u, int wr, int wc, int fr, int fq) const {
        const int row0 = u.pm * BM + wr * 64 + fr, col0 = (u.pn & 3) * HALF + wc * 32 + 8 * fq;
#pragma unroll
        for (int ai = 0; ai < 2; ++ai)
#pragma unroll
            for (int m = 0; m < 4; ++m) { bf16_t* rowp = O + (size_t)(row0 + ai * HALF + m * 16) * 512 + col0;
                float h[8];
#pragma unroll
                for (int n = 0; n < 2; ++n)
#pragma unroll
                    for (int j = 0; j < 4; ++j) { const float g = acc[ai][0][m][n][j], up = acc[ai][1][m][n][j]; h[4 * n + j] = g * __builtin_amdgcn_rcpf(1.0f + __expf(-g)) * up; }
                u32x4 w; w.x = cvt_pk_bf16(h[0], h[1]); w.y = cvt_pk_bf16(h[2], h[3]); w.z = cvt_pk_bf16(h[4], h[5]); w.w = cvt_pk_bf16(h[6], h[7]);
                *(u32x4*)rowp = w; }
    }
};
struct EpiSwiGLUPub {
    static constexpr bool PERM = true, AFTER_DRAIN = false;
    bf16_t* O; unsigned bytes;
    __device__ __forceinline__ void operator()(const f32x4 (&acc)[2][2][4][2], const Unit& u, int wr, int wc, int fr, int fq) const {
        const __amdgpu_buffer_rsrc_t rs = __builtin_amdgcn_make_buffer_rsrc(O, 0, bytes, 0x00020000);
        const int row0 = u.pm * BM + wr * 64 + fr, col0 = (u.pn & 3) * HALF + wc * 32 + 8 * fq;
#pragma unroll
        for (int ai = 0; ai < 2; ++ai)
#pragma unroll
            for (int m = 0; m < 4; ++m) { const unsigned off = (unsigned)((row0 + ai * HALF + m * 16) * 512 + col0) * 2u;
                float h[8];
#pragma unroll
                for (int n = 0; n < 2; ++n)
#pragma unroll
                    for (int j = 0; j < 4; ++j) { const float g = acc[ai][0][m][n][j], up = acc[ai][1][m][n][j]; h[4 * n + j] = g * __builtin_amdgcn_rcpf(1.0f + __expf(-g)) * up; }
                u32x4 w; w.x = cvt_pk_bf16(h[0], h[1]); w.y = cvt_pk_bf16(h[2], h[3]); w.z = cvt_pk_bf16(h[4], h[5]); w.w = cvt_pk_bf16(h[6], h[7]);
                __builtin_amdgcn_raw_buffer_store_b128(w, rs, off, 0,   16); }
    }
};
struct EpiDown {
    static constexpr bool PERM = true, AFTER_DRAIN = false;
    bf16_t* O;
    __device__ __forceinline__ void operator()(const f32x4 (&acc)[2][2][4][2], const Unit& u, int wr, int wc, int fr, int fq) const {
        const int row0 = u.pm * BM + wr * 64 + fr, col0 = (u.pn & 7) * BM + wc * 32 + 8 * fq;
#pragma unroll
        for (int ai = 0; ai < 2; ++ai)
#pragma unroll
            for (int m = 0; m < 4; ++m) { bf16_t* rowp = O + (size_t)(row0 + ai * HALF + m * 16) * 2048 + col0;
#pragma unroll
                for (int bj = 0; bj < 2; ++bj) { const f32x4 v0 = acc[ai][bj][m][0], v1 = acc[ai][bj][m][1];
                    u32x4 w; w.x = cvt_pk_bf16(v0[0], v0[1]); w.y = cvt_pk_bf16(v0[2], v0[3]); w.z = cvt_pk_bf16(v1[0], v1[1]); w.w = cvt_pk_bf16(v1[2], v1[3]);
                    *(u32x4*)(rowp + bj * HALF) = w; } }
    }
};
struct Order64 : StaticOrder {
    __device__ __forceinline__ bool next(int i, Unit& u) const { if (!StaticOrder::next(i, u)) return false; u.pm += (u.pm >= 32); return true; }
};
struct Order64Range : Order64 {
    int i0, i1;
    __device__ __forceinline__ bool next(int i, Unit& u) const { return (i0 + i < i1) && Order64::next(i0 + i, u); }
};
struct MoeOrder {
    int NB, ncol, nwg, G, c; const PG8_LAS int* blk_e;
    __device__ __forceinline__ bool next(int i, Unit& u) const {
        const long L = (long)i * G + c; if (L >= nwg) return false;
        int wgid = (int)L; { const int q = nwg / NXCD, r = nwg % NXCD, xcd = wgid % NXCD, off = wgid / NXCD; wgid = (xcd < r ? xcd * (q + 1) : r * (q + 1) + (xcd - r) * q) + off; }
        const int rb = wgid / ncol, pnl = wgid - rb * ncol;
        u.pm = rb; u.pn = blk_e[rb] * ncol + pnl; return true;
    }
    __device__ __forceinline__ void a_ready(const Unit&) const {}
    __device__ __forceinline__ void done(const Unit&) const {}
};
struct MoeOrderPub : MoeOrder {
    unsigned* ready;
    __device__ __forceinline__ void done(const Unit& u) const {
        asm volatile("s_waitcnt vmcnt(0)" ::: "memory");
        if ((threadIdx.x & 63) == 0) __hip_atomic_fetch_add(ready + 16 * u.pm, 1u, __ATOMIC_RELAXED, __HIP_MEMORY_SCOPE_AGENT);
    }
};
struct MoeOrderDyn {
    int NB, x; const PG8_LAS int* blk_e; unsigned* tickets; const unsigned* ready; unsigned* tmo; PG8_LAS int* slot;
    __device__ __forceinline__ unsigned issue() const { unsigned t = 0u; if (threadIdx.x == 0) t = __hip_atomic_fetch_add(tickets + 16 * x, 1u, __ATOMIC_RELAXED, __HIP_MEMORY_SCOPE_AGENT); return t; }
    __device__ __forceinline__ bool resolve(unsigned tk, int ui, Unit& u) const {
        if (threadIdx.x == 0) { int w = -1;
            if (tk < (unsigned)NB) w = x * NB + (int)tk;
            else { for (int k = 1; k < NXCD; ++k) { const int xx = (x + k) & (NXCD - 1); const unsigned t2 = __hip_atomic_fetch_add(tickets + 16 * xx, 1u, __ATOMIC_RELAXED, __HIP_MEMORY_SCOPE_AGENT); if (t2 < (unsigned)NB) { w = xx * NB + (int)t2; break; } } }
            if (w >= 0) { const unsigned* r = ready + 16 * (w >> 3); unsigned polls = 0;
                while (__hip_atomic_load(r, __ATOMIC_RELAXED, __HIP_MEMORY_SCOPE_AGENT) < 32u) { __builtin_amdgcn_s_sleep(1); if (++polls > (1u << 22)) { __hip_atomic_store(tmo, 1u, __ATOMIC_RELAXED, __HIP_MEMORY_SCOPE_AGENT); break; } }
                __builtin_amdgcn_fence(__ATOMIC_ACQUIRE, "agent"); asm volatile("s_waitcnt vmcnt(0)" ::: "memory"); }
            slot[ui & 1] = w; }
        asm volatile("s_waitcnt lgkmcnt(0)" ::: "memory"); __builtin_amdgcn_s_barrier(); asm volatile("" ::: "memory");
        const int w = __builtin_amdgcn_readfirstlane(slot[ui & 1]);
        if (w < 0) return false;
        u.pm = w >> 3; u.pn = blk_e[w >> 3] * 8 + (w & 7); return true;
    }
    __device__ __forceinline__ void done(const Unit&) const {}
};
template <class Epi, class Sched, bool ALIGN_EPI = false, bool SP2 = false>
__device__ __forceinline__ void gemm_phase(PG8_LAS unsigned char* lds, const Gemm g, const Sched& S, const Epi& E) {
    const int tid = threadIdx.x, wid = __builtin_amdgcn_readfirstlane(tid >> 6), lane = tid & 63, wr = wid >> 2, wc = wid & 3, fr = lane & 15, fq = lane >> 4;
    const int K = g.K, nt = K / BK;
    unsigned voffA[2], voffB[2];
#pragma unroll
    for (int i = 0; i < 2; ++i) { int R, C; stage_rc(tid * 16 + i * 8192, R, C); const int Rb = Epi::PERM ? ((R & ~31) + perm32(R & 31)) : R;
        voffA[i] = (unsigned)(R * K + C) * 2u; voffB[i] = (unsigned)(Rb * K + C) * 2u; }
    const size_t kstep = (size_t)(BK * 2);
    const size_t hstep = (size_t)HALF * K * 2;
    const size_t tstep = 2 * hstep;
    const unsigned ldsw = (unsigned)wid * 1024u;
    const int aoff = lds_byte(wr * 64 + fr, fq * 8), boff = lds_byte(wc * 32 + fr, fq * 8);
#define PG8_SA(b, h) (((b) * 2 + (h)) * HTB)
#define PG8_SB(b, h) ((4 + (b) * 2 + (h)) * HTB)
#define PG8_STAGE(bufoff, gbase, voff) do { _Pragma("unroll") for (int _i = 0; _i < 2; ++_i) \
        __builtin_amdgcn_global_load_lds((const unsigned*)((const char*)(gbase) + (voff)[_i]), (PG8_LAS unsigned*)(lds + (bufoff) + ldsw + _i * 8192), 16, 0, 0); } while (0)
#define PG8_LDA(dst, b, h) do { _Pragma("unroll") for (int m = 0; m < 4; ++m) _Pragma("unroll") for (int k = 0; k < 2; ++k) dst[m][k] = *(const PG8_LAS bf16x8*)(lds + PG8_SA(b, h) + aoff + m * 2048 + k * 1024); } while (0)
#define PG8_LDB(dst, b, h) do { _Pragma("unroll") for (int n = 0; n < 2; ++n) _Pragma("unroll") for (int k = 0; k < 2; ++k) dst[n][k] = *(const PG8_LAS bf16x8*)(lds + PG8_SB(b, h) + boff + n * 2048 + k * 1024); } while (0)
#define PG8_MMA(ai, bj, At, Bt) do { __builtin_amdgcn_s_setprio(1); _Pragma("unroll") for (int m = 0; m < 4; ++m) _Pragma("unroll") for (int n = 0; n < 2; ++n) _Pragma("unroll") for (int k = 0; k < 2; ++k) \
        acc[ai][bj][m][n] = __builtin_amdgcn_mfma_f32_16x16x32_bf16(Bt[n][k], At[m][k], acc[ai][bj][m][n], 0, 0, 0); __builtin_amdgcn_s_setprio(0); } while (0)
#define PG8_WAIT_V(n) asm volatile("s_waitcnt vmcnt(" #n ")" ::: "memory")
#define PG8_WAIT_L(n) asm volatile("s_waitcnt lgkmcnt(" #n ")" ::: "memory")
#define PG8_BAR __builtin_amdgcn_s_barrier()
#define PG8_SCHED __builtin_amdgcn_sched_barrier(0)
    Unit cur, nxt; int ui = 0;
    if (!S.next(0, cur)) return;
    f32x4 acc[2][2][4][2];
#pragma unroll
    for (int a = 0; a < 2; ++a)
#pragma unroll
        for (int b = 0; b < 2; ++b)
#pragma unroll
            for (int m = 0; m < 4; ++m)
#pragma unroll
                for (int n = 0; n < 2; ++n) acc[a][b][m][n] = (f32x4){0.f, 0.f, 0.f, 0.f};
    bf16x8 At[4][2], B0[2][2], B1[2][2];
    const char* cA = (const char*)g.A + (size_t)cur.pm * tstep; const char* cB = (const char*)g.Bt + (size_t)cur.pn * tstep;
    S.a_ready(cur);
    if constexpr (SP2) {
        PG8_STAGE(PG8_SB(0, 0), cB, voffB); PG8_STAGE(PG8_SB(0, 1), cB + hstep, voffB); PG8_STAGE(PG8_SA(0, 0), cA, voffA); PG8_STAGE(PG8_SA(0, 1), cA + hstep, voffA);
        if (wr == 1) PG8_BAR;
        PG8_WAIT_V(2); PG8_BAR;
        PG8_STAGE(PG8_SB(1, 0), cB + kstep, voffB); PG8_STAGE(PG8_SA(1, 0), cA + kstep, voffA); PG8_STAGE(PG8_SB(1, 1), cB + hstep + kstep, voffB);
        PG8_WAIT_V(6); PG8_BAR;
    } else {
        PG8_STAGE(PG8_SB(0, 0), cB, voffB); PG8_STAGE(PG8_SA(0, 0), cA, voffA); PG8_STAGE(PG8_SB(0, 1), cB + hstep, voffB); PG8_STAGE(PG8_SA(0, 1), cA + hstep, voffA);
        if (wr == 1) PG8_BAR;
        PG8_WAIT_V(4); PG8_BAR;
        PG8_STAGE(PG8_SB(1, 0), cB + kstep, voffB); PG8_STAGE(PG8_SA(1, 0), cA + kstep, voffA); PG8_STAGE(PG8_SB(1, 1), cB + hstep + kstep, voffB);
        PG8_WAIT_V(6); PG8_BAR;
    }
    for (;;) {
        const bool has_next = S.next(ui + 1, nxt);
        const char* nA = has_next ? (const char*)g.A + (size_t)nxt.pm * tstep : cA; const char* nB = has_next ? (const char*)g.Bt + (size_t)nxt.pn * tstep : cB;
        for (int t = 0; t < nt; t += 2) {
            const bool last = (t == nt - 2);
            const char* a1 = cA + (size_t)(t + 1) * kstep;
            const char* a2 = last ? nA : cA + (size_t)(t + 2) * kstep; const char* b2 = last ? nB : cB + (size_t)(t + 2) * kstep;
            const char* a3 = a2 + kstep; const char* b3 = b2 + kstep;
            if (last && has_next) S.a_ready(nxt);
            if constexpr (SP2) {
            PG8_LDB(B0, 0, 0); PG8_LDB(B1, 0, 1); PG8_SCHED; PG8_LDA(At, 0, 0); PG8_STAGE(PG8_SA(1, 1), a1 + hstep, voffA);
            PG8_WAIT_V(8); PG8_WAIT_L(0); PG8_BAR; PG8_MMA(0, 0, At, B0); PG8_MMA(0, 1, At, B1); PG8_BAR; PG8_SCHED;
            PG8_LDA(At, 0, 1); PG8_STAGE(PG8_SB(0, 0), b2, voffB); PG8_STAGE(PG8_SB(0, 1), b2 + hstep, voffB); PG8_STAGE(PG8_SA(0, 0), a2, voffA);
            PG8_WAIT_V(8); PG8_WAIT_L(0); PG8_BAR; PG8_MMA(1, 0, At, B0); PG8_MMA(1, 1, At, B1); PG8_BAR; PG8_SCHED;
            PG8_LDB(B0, 1, 0); PG8_LDB(B1, 1, 1); PG8_SCHED; PG8_LDA(At, 1, 0); PG8_STAGE(PG8_SA(0, 1), a2 + hstep, voffA);
            PG8_WAIT_V(8); PG8_WAIT_L(0); PG8_BAR; PG8_MMA(0, 0, At, B0); PG8_MMA(0, 1, At, B1); PG8_BAR; PG8_SCHED;
            PG8_LDA(At, 1, 1); PG8_STAGE(PG8_SB(1, 0), b3, voffB); PG8_STAGE(PG8_SB(1, 1), b3 + hstep, voffB); PG8_STAGE(PG8_SA(1, 0), a3, voffA);
            PG8_WAIT_V(8); PG8_WAIT_L(0); PG8_BAR; PG8_MMA(1, 0, At, B0); PG8_MMA(1, 1, At, B1); PG8_BAR; PG8_SCHED;
            } else {
            PG8_LDB(B0, 0, 0); PG8_SCHED; PG8_LDA(At, 0, 0); PG8_STAGE(PG8_SA(1, 1), a1 + hstep, voffA);
            PG8_WAIT_L(8); PG8_BAR; PG8_WAIT_L(0); PG8_MMA(0, 0, At, B0); PG8_BAR; PG8_SCHED;
            PG8_LDB(B1, 0, 1); PG8_STAGE(PG8_SB(0, 0), b2, voffB);
            PG8_BAR; PG8_WAIT_L(0); PG8_MMA(0, 1, At, B1); PG8_BAR;
            PG8_LDA(At, 0, 1); PG8_STAGE(PG8_SA(0, 0), a2, voffA);
            PG8_BAR; PG8_WAIT_L(0); PG8_MMA(1, 0, At, B0); PG8_BAR; PG8_SCHED;
            PG8_STAGE(PG8_SB(0, 1), b2 + hstep, voffB);
            PG8_WAIT_V(6); PG8_BAR; PG8_MMA(1, 1, At, B1); PG8_BAR;
            PG8_LDB(B0, 1, 0); PG8_SCHED; PG8_LDA(At, 1, 0); PG8_STAGE(PG8_SA(0, 1), a2 + hstep, voffA);
            PG8_WAIT_L(8); PG8_BAR; PG8_WAIT_L(0); PG8_MMA(0, 0, At, B0); PG8_BAR; PG8_SCHED;
            PG8_LDB(B1, 1, 1); PG8_STAGE(PG8_SB(1, 0), b3, voffB);
            PG8_BAR; PG8_WAIT_L(0); PG8_MMA(0, 1, At, B1); PG8_BAR;
            PG8_LDA(At, 1, 1); PG8_STAGE(PG8_SA(1, 0), a3, voffA);
            PG8_BAR; PG8_WAIT_L(0); PG8_MMA(1, 0, At, B0); PG8_BAR; PG8_SCHED;
            PG8_STAGE(PG8_SB(1, 1), b3 + hstep, voffB);
            PG8_WAIT_V(6); PG8_BAR; PG8_MMA(1, 1, At, B1); PG8_BAR;
            }
        }
        if constexpr (ALIGN_EPI) { if (wr == 0) PG8_BAR; }
        if constexpr (!Epi::AFTER_DRAIN) { E(acc, cur, wr, wc, fr, fq); S.done(cur); }
        if (!has_next) break;
#pragma unroll
        for (int a = 0; a < 2; ++a)
#pragma unroll
            for (int b = 0; b < 2; ++b)
#pragma unroll
                for (int m = 0; m < 4; ++m)
#pragma unroll
                    for (int n = 0; n < 2; ++n) acc[a][b][m][n] = (f32x4){0.f, 0.f, 0.f, 0.f};
        cur = nxt; cA = nA; cB = nB; ++ui;
        if constexpr (ALIGN_EPI) { if (wr == 1) PG8_BAR; }
    }
    PG8_WAIT_V(0);
    if constexpr (!ALIGN_EPI) { if (wr == 0) PG8_BAR; }
    PG8_BAR;
    if constexpr (Epi::AFTER_DRAIN) { E.fused(acc, cur, wr, wc, fr, fq, lds, wid, lane); S.done(cur); }
#undef PG8_SA
#undef PG8_SB
#undef PG8_STAGE
#undef PG8_LDA
#undef PG8_LDB
#undef PG8_MMA
#undef PG8_WAIT_V
#undef PG8_WAIT_L
#undef PG8_BAR
#undef PG8_SCHED
}
template <class Epi, class Sched>
__device__ __forceinline__ void gemm_phase_dyn(PG8_LAS unsigned char* lds, const Gemm g, const Sched& S, const Epi& E) {
    constexpr bool ALIGN_EPI = true, SP2 = true;
    const int tid = threadIdx.x, wid = __builtin_amdgcn_readfirstlane(tid >> 6), lane = tid & 63, wr = wid >> 2, wc = wid & 3, fr = lane & 15, fq = lane >> 4;
    const int K = g.K, nt = K / BK;
    unsigned voffA[2], voffB[2];
#pragma unroll
    for (int i = 0; i < 2; ++i) { int R, C; stage_rc(tid * 16 + i * 8192, R, C); const int Rb = Epi::PERM ? ((R & ~31) + perm32(R & 31)) : R;
        voffA[i] = (unsigned)(R * K + C) * 2u; voffB[i] = (unsigned)(Rb * K + C) * 2u; }
    const size_t kstep = (size_t)(BK * 2);
    const size_t hstep = (size_t)HALF * K * 2;
    const size_t tstep = 2 * hstep;
    const unsigned ldsw = (unsigned)wid * 1024u;
    const int aoff = lds_byte(wr * 64 + fr, fq * 8), boff = lds_byte(wc * 32 + fr, fq * 8);
#define PG8_SA(b, h) (((b) * 2 + (h)) * HTB)
#define PG8_SB(b, h) ((4 + (b) * 2 + (h)) * HTB)
#define PG8_STAGE(bufoff, gbase, voff) do { _Pragma("unroll") for (int _i = 0; _i < 2; ++_i) \
        __builtin_amdgcn_global_load_lds((const unsigned*)((const char*)(gbase) + (voff)[_i]), (PG8_LAS unsigned*)(lds + (bufoff) + ldsw + _i * 8192), 16, 0, 0); } while (0)
#define PG8_LDA(dst, b, h) do { _Pragma("unroll") for (int m = 0; m < 4; ++m) _Pragma("unroll") for (int k = 0; k < 2; ++k) dst[m][k] = *(const PG8_LAS bf16x8*)(lds + PG8_SA(b, h) + aoff + m * 2048 + k * 1024); } while (0)
#define PG8_LDB(dst, b, h) do { _Pragma("unroll") for (int n = 0; n < 2; ++n) _Pragma("unroll") for (int k = 0; k < 2; ++k) dst[n][k] = *(const PG8_LAS bf16x8*)(lds + PG8_SB(b, h) + boff + n * 2048 + k * 1024); } while (0)
#define PG8_MMA(ai, bj, At, Bt) do { __builtin_amdgcn_s_setprio(1); _Pragma("unroll") for (int m = 0; m < 4; ++m) _Pragma("unroll") for (int n = 0; n < 2; ++n) _Pragma("unroll") for (int k = 0; k < 2; ++k) \
        acc[ai][bj][m][n] = __builtin_amdgcn_mfma_f32_16x16x32_bf16(Bt[n][k], At[m][k], acc[ai][bj][m][n], 0, 0, 0); __builtin_amdgcn_s_setprio(0); } while (0)
#define PG8_WAIT_V(n) asm volatile("s_waitcnt vmcnt(" #n ")" ::: "memory")
#define PG8_WAIT_L(n) asm volatile("s_waitcnt lgkmcnt(" #n ")" ::: "memory")
#define PG8_BAR __builtin_amdgcn_s_barrier()
#define PG8_SCHED __builtin_amdgcn_sched_barrier(0)
    Unit cur, nxt; int ui = 0;
    { const unsigned tk0 = S.issue(); if (!S.resolve(tk0, 0, cur)) return; }
    f32x4 acc[2][2][4][2];
#pragma unroll
    for (int a = 0; a < 2; ++a)
#pragma unroll
        for (int b = 0; b < 2; ++b)
#pragma unroll
            for (int m = 0; m < 4; ++m)
#pragma unroll
                for (int n = 0; n < 2; ++n) acc[a][b][m][n] = (f32x4){0.f, 0.f, 0.f, 0.f};
    bf16x8 At[4][2], B0[2][2], B1[2][2];
    const char* cA = (const char*)g.A + (size_t)cur.pm * tstep; const char* cB = (const char*)g.Bt + (size_t)cur.pn * tstep;
    if constexpr (SP2) {
        PG8_STAGE(PG8_SB(0, 0), cB, voffB); PG8_STAGE(PG8_SB(0, 1), cB + hstep, voffB); PG8_STAGE(PG8_SA(0, 0), cA, voffA); PG8_STAGE(PG8_SA(0, 1), cA + hstep, voffA);
        if (wr == 1) PG8_BAR;
        PG8_WAIT_V(2); PG8_BAR;
        PG8_STAGE(PG8_SB(1, 0), cB + kstep, voffB); PG8_STAGE(PG8_SA(1, 0), cA + kstep, voffA); PG8_STAGE(PG8_SB(1, 1), cB + hstep + kstep, voffB);
        PG8_WAIT_V(6); PG8_BAR;
    } else {
        PG8_STAGE(PG8_SB(0, 0), cB, voffB); PG8_STAGE(PG8_SA(0, 0), cA, voffA); PG8_STAGE(PG8_SB(0, 1), cB + hstep, voffB); PG8_STAGE(PG8_SA(0, 1), cA + hstep, voffA);
        if (wr == 1) PG8_BAR;
        PG8_WAIT_V(4); PG8_BAR;
        PG8_STAGE(PG8_SB(1, 0), cB + kstep, voffB); PG8_STAGE(PG8_SA(1, 0), cA + kstep, voffA); PG8_STAGE(PG8_SB(1, 1), cB + hstep + kstep, voffB);
        PG8_WAIT_V(6); PG8_BAR;
    }
    for (;;) {
        bool has_next = false; const char* nA = cA; const char* nB = cB;
        const unsigned tk = S.issue();
        for (int t = 0; t < nt; t += 2) {
            const bool last = (t == nt - 2);
            if (last) { has_next = S.resolve(tk, ui + 1, nxt); if (has_next) { nA = (const char*)g.A + (size_t)nxt.pm * tstep; nB = (const char*)g.Bt + (size_t)nxt.pn * tstep; } }
            const char* a1 = cA + (size_t)(t + 1) * kstep;
            const char* a2 = last ? nA : cA + (size_t)(t + 2) * kstep; const char* b2 = last ? nB : cB + (size_t)(t + 2) * kstep;
            const char* a3 = a2 + kstep; const char* b3 = b2 + kstep;
            if constexpr (SP2) {
            PG8_LDB(B0, 0, 0); PG8_LDB(B1, 0, 1); PG8_SCHED; PG8_LDA(At, 0, 0); PG8_STAGE(PG8_SA(1, 1), a1 + hstep, voffA);
            PG8_WAIT_V(8); PG8_WAIT_L(0); PG8_BAR; PG8_MMA(0, 0, At, B0); PG8_MMA(0, 1, At, B1); PG8_BAR; PG8_SCHED;
            PG8_LDA(At, 0, 1); PG8_STAGE(PG8_SB(0, 0), b2, voffB); PG8_STAGE(PG8_SB(0, 1), b2 + hstep, voffB); PG8_STAGE(PG8_SA(0, 0), a2, voffA);
            PG8_WAIT_V(8); PG8_WAIT_L(0); PG8_BAR; PG8_MMA(1, 0, At, B0); PG8_MMA(1, 1, At, B1); PG8_BAR; PG8_SCHED;
            PG8_LDB(B0, 1, 0); PG8_LDB(B1, 1, 1); PG8_SCHED; PG8_LDA(At, 1, 0); PG8_STAGE(PG8_SA(0, 1), a2 + hstep, voffA);
            PG8_WAIT_V(8); PG8_WAIT_L(0); PG8_BAR; PG8_MMA(0, 0, At, B0); PG8_MMA(0, 1, At, B1); PG8_BAR; PG8_SCHED;
            PG8_LDA(At, 1, 1); PG8_STAGE(PG8_SB(1, 0), b3, voffB); PG8_STAGE(PG8_SB(1, 1), b3 + hstep, voffB); PG8_STAGE(PG8_SA(1, 0), a3, voffA);
            PG8_WAIT_V(8); PG8_WAIT_L(0); PG8_BAR; PG8_MMA(1, 0, At, B0); PG8_MMA(1, 1, At, B1); PG8_BAR; PG8_SCHED;
            } else {
            PG8_LDB(B0, 0, 0); PG8_SCHED; PG8_LDA(At, 0, 0); PG8_STAGE(PG8_SA(1, 1), a1 + hstep, voffA);
            PG8_WAIT_L(8); PG8_BAR; PG8_WAIT_L(0); PG8_MMA(0, 0, At, B0); PG8_BAR; PG8_SCHED;
            PG8_LDB(B1, 0, 1); PG8_STAGE(PG8_SB(0, 0), b2, voffB);
            PG8_BAR; PG8_WAIT_L(0); PG8_MMA(0, 1, At, B1); PG8_BAR;
            PG8_LDA(At, 0, 1); PG8_STAGE(PG8_SA(0, 0), a2, voffA);
            PG8_BAR; PG8_WAIT_L(0); PG8_MMA(1, 0, At, B0); PG8_BAR; PG8_SCHED;
            PG8_STAGE(PG8_SB(0, 1), b2 + hstep, voffB);
            PG8_WAIT_V(6); PG8_BAR; PG8_MMA(1, 1, At, B1); PG8_BAR;
            PG8_LDB(B0, 1, 0); PG8_SCHED; PG8_LDA(At, 1, 0); PG8_STAGE(PG8_SA(0, 1), a2 + hstep, voffA);
            PG8_WAIT_L(8); PG8_BAR; PG8_WAIT_L(0); PG8_MMA(0, 0, At, B0); PG8_BAR; PG8_SCHED;
            PG8_LDB(B1, 1, 1); PG8_STAGE(PG8_SB(1, 0), b3, voffB);
            PG8_BAR; PG8_WAIT_L(0); PG8_MMA(0, 1, At, B1); PG8_BAR;
            PG8_LDA(At, 1, 1); PG8_STAGE(PG8_SA(1, 0), a3, voffA);
            PG8_BAR; PG8_WAIT_L(0); PG8_MMA(1, 0, At, B0); PG8_BAR; PG8_SCHED;
            PG8_STAGE(PG8_SB(1, 1), b3 + hstep, voffB);
            PG8_WAIT_V(6); PG8_BAR; PG8_MMA(1, 1, At, B1); PG8_BAR;
            }
        }
        if constexpr (ALIGN_EPI) { if (wr == 0) PG8_BAR; }
        if constexpr (!Epi::AFTER_DRAIN) { E(acc, cur, wr, wc, fr, fq); S.done(cur); }
        if (!has_next) break;
#pragma unroll
        for (int a = 0; a < 2; ++a)
#pragma unroll
            for (int b = 0; b < 2; ++b)
#pragma unroll
                for (int m = 0; m < 4; ++m)
#pragma unroll
                    for (int n = 0; n < 2; ++n) acc[a][b][m][n] = (f32x4){0.f, 0.f, 0.f, 0.f};
        cur = nxt; cA = nA; cB = nB; ++ui;
        if constexpr (ALIGN_EPI) { if (wr == 1) PG8_BAR; }
    }
    PG8_WAIT_V(0);
    if constexpr (!ALIGN_EPI) { if (wr == 0) PG8_BAR; }
    PG8_BAR;
    if constexpr (Epi::AFTER_DRAIN) { E.fused(acc, cur, wr, wc, fr, fq, lds, wid, lane); S.done(cur); }
#undef PG8_SA
#undef PG8_SB
#undef PG8_STAGE
#undef PG8_LDA
#undef PG8_LDB
#undef PG8_MMA
#undef PG8_WAIT_V
#undef PG8_WAIT_L
#undef PG8_BAR
#undef PG8_SCHED
}
template <class Epi, class Sched>
__device__ __forceinline__ void gemm_phase_gather(PG8_LAS unsigned char* lds, const Gemm g, const Sched& S, const Epi& E, const int* rowtok) {
    constexpr bool ALIGN_EPI = true, SP2 = true;
    const int tid = threadIdx.x, wid = __builtin_amdgcn_readfirstlane(tid >> 6), lane = tid & 63, wr = wid >> 2, wc = wid & 3, fr = lane & 15, fq = lane >> 4;
    const int K = g.K, nt = K / BK;
    unsigned voffA[2], voffB[2]; int rA[2];
#pragma unroll
    for (int i = 0; i < 2; ++i) { int R, C; stage_rc(tid * 16 + i * 8192, R, C); const int Rb = Epi::PERM ? ((R & ~31) + perm32(R & 31)) : R;
        voffA[i] = (unsigned)C * 2u; voffB[i] = (unsigned)(Rb * K + C) * 2u; rA[i] = R; }
    const size_t kstep = (size_t)(BK * 2);
    const size_t hstep = (size_t)HALF * K * 2;
    const size_t tstep = 2 * hstep;
    const unsigned ldsw = (unsigned)wid * 1024u;
    const int aoff = lds_byte(wr * 64 + fr, fq * 8), boff = lds_byte(wc * 32 + fr, fq * 8);
#define PG8_SA(b, h) (((b) * 2 + (h)) * HTB)
#define PG8_SB(b, h) ((4 + (b) * 2 + (h)) * HTB)
#define PG8_STAGE(bufoff, gbase, voff) do { _Pragma("unroll") for (int _i = 0; _i < 2; ++_i) \
        __builtin_amdgcn_global_load_lds((const unsigned*)((const char*)(gbase) + (voff)[_i]), (PG8_LAS unsigned*)(lds + (bufoff) + ldsw + _i * 8192), 16, 0, 0); } while (0)
#define PG8_LDA(dst, b, h) do { _Pragma("unroll") for (int m = 0; m < 4; ++m) _Pragma("unroll") for (int k = 0; k < 2; ++k) dst[m][k] = *(const PG8_LAS bf16x8*)(lds + PG8_SA(b, h) + aoff + m * 2048 + k * 1024); } while (0)
#define PG8_LDB(dst, b, h) do { _Pragma("unroll") for (int n = 0; n < 2; ++n) _Pragma("unroll") for (int k = 0; k < 2; ++k) dst[n][k] = *(const PG8_LAS bf16x8*)(lds + PG8_SB(b, h) + boff + n * 2048 + k * 1024); } while (0)
#define PG8_MMA(ai, bj, At, Bt) do { __builtin_amdgcn_s_setprio(1); _Pragma("unroll") for (int m = 0; m < 4; ++m) _Pragma("unroll") for (int n = 0; n < 2; ++n) _Pragma("unroll") for (int k = 0; k < 2; ++k) \
        acc[ai][bj][m][n] = __builtin_amdgcn_mfma_f32_16x16x32_bf16(Bt[n][k], At[m][k], acc[ai][bj][m][n], 0, 0, 0); __builtin_amdgcn_s_setprio(0); } while (0)
#define PG8_WAIT_V(n) asm volatile("s_waitcnt vmcnt(" #n ")" ::: "memory")
#define PG8_WAIT_L(n) asm volatile("s_waitcnt lgkmcnt(" #n ")" ::: "memory")
#define PG8_BAR __builtin_amdgcn_s_barrier()
#define PG8_SCHED __builtin_amdgcn_sched_barrier(0)
    Unit cur, nxt; int ui = 0;
    if (!S.next(0, cur)) return;
    f32x4 acc[2][2][4][2];
#pragma unroll
    for (int a = 0; a < 2; ++a)
#pragma unroll
        for (int b = 0; b < 2; ++b)
#pragma unroll
            for (int m = 0; m < 4; ++m)
#pragma unroll
                for (int n = 0; n < 2; ++n) acc[a][b][m][n] = (f32x4){0.f, 0.f, 0.f, 0.f};
    bf16x8 At[4][2], B0[2][2], B1[2][2];
    const char* cA = (const char*)g.A; const char* cB = (const char*)g.Bt + (size_t)cur.pn * tstep;
    unsigned gC0[2], gC1[2], gN0[2], gN1[2];
#pragma unroll
    for (int i = 0; i < 2; ++i) { gC0[i] = (unsigned)rowtok[cur.pm * BM + rA[i]] * (unsigned)(K * 2) + voffA[i]; gC1[i] = (unsigned)rowtok[cur.pm * BM + HALF + rA[i]] * (unsigned)(K * 2) + voffA[i]; }
    S.a_ready(cur);
    if constexpr (SP2) {
        PG8_STAGE(PG8_SB(0, 0), cB, voffB); PG8_STAGE(PG8_SB(0, 1), cB + hstep, voffB); PG8_STAGE(PG8_SA(0, 0), cA, gC0); PG8_STAGE(PG8_SA(0, 1), cA, gC1);
        if (wr == 1) PG8_BAR;
        PG8_WAIT_V(2); PG8_BAR;
        PG8_STAGE(PG8_SB(1, 0), cB + kstep, voffB); PG8_STAGE(PG8_SA(1, 0), cA + kstep, gC0); PG8_STAGE(PG8_SB(1, 1), cB + hstep + kstep, voffB);
        PG8_WAIT_V(6); PG8_BAR;
    } else {
        PG8_STAGE(PG8_SB(0, 0), cB, voffB); PG8_STAGE(PG8_SA(0, 0), cA, voffA); PG8_STAGE(PG8_SB(0, 1), cB + hstep, voffB); PG8_STAGE(PG8_SA(0, 1), cA + hstep, voffA);
        if (wr == 1) PG8_BAR;
        PG8_WAIT_V(4); PG8_BAR;
        PG8_STAGE(PG8_SB(1, 0), cB + kstep, voffB); PG8_STAGE(PG8_SA(1, 0), cA + kstep, voffA); PG8_STAGE(PG8_SB(1, 1), cB + hstep + kstep, voffB);
        PG8_WAIT_V(6); PG8_BAR;
    }
    for (;;) {
        const bool has_next = S.next(ui + 1, nxt);
        const char* nB = has_next ? (const char*)g.Bt + (size_t)nxt.pn * tstep : cB;
#pragma unroll
        for (int i = 0; i < 2; ++i) { gN0[i] = has_next ? (unsigned)rowtok[nxt.pm * BM + rA[i]] * (unsigned)(K * 2) + voffA[i] : gC0[i]; gN1[i] = has_next ? (unsigned)rowtok[nxt.pm * BM + HALF + rA[i]] * (unsigned)(K * 2) + voffA[i] : gC1[i]; }
        for (int t = 0; t < nt; t += 2) {
            const bool last = (t == nt - 2);
            const char* a1 = cA + (size_t)(t + 1) * kstep;
            const char* a2 = last ? cA : cA + (size_t)(t + 2) * kstep; const char* b2 = last ? nB : cB + (size_t)(t + 2) * kstep;
            unsigned g20[2], g21[2];
#pragma unroll
            for (int i = 0; i < 2; ++i) { g20[i] = last ? gN0[i] : gC0[i]; g21[i] = last ? gN1[i] : gC1[i]; }
            const char* a3 = a2 + kstep; const char* b3 = b2 + kstep;
            if (last && has_next) S.a_ready(nxt);
            if constexpr (SP2) {
            PG8_LDB(B0, 0, 0); PG8_LDB(B1, 0, 1); PG8_SCHED; PG8_LDA(At, 0, 0); PG8_STAGE(PG8_SA(1, 1), a1, gC1);
            PG8_WAIT_V(8); PG8_WAIT_L(0); PG8_BAR; PG8_MMA(0, 0, At, B0); PG8_MMA(0, 1, At, B1); PG8_BAR; PG8_SCHED;
            PG8_LDA(At, 0, 1); PG8_STAGE(PG8_SB(0, 0), b2, voffB); PG8_STAGE(PG8_SB(0, 1), b2 + hstep, voffB); PG8_STAGE(PG8_SA(0, 0), a2, g20);
            PG8_WAIT_V(8); PG8_WAIT_L(0); PG8_BAR; PG8_MMA(1, 0, At, B0); PG8_MMA(1, 1, At, B1); PG8_BAR; PG8_SCHED;
            PG8_LDB(B0, 1, 0); PG8_LDB(B1, 1, 1); PG8_SCHED; PG8_LDA(At, 1, 0); PG8_STAGE(PG8_SA(0, 1), a2, g21);
            PG8_WAIT_V(8); PG8_WAIT_L(0); PG8_BAR; PG8_MMA(0, 0, At, B0); PG8_MMA(0, 1, At, B1); PG8_BAR; PG8_SCHED;
            PG8_LDA(At, 1, 1); PG8_STAGE(PG8_SB(1, 0), b3, voffB); PG8_STAGE(PG8_SB(1, 1), b3 + hstep, voffB); PG8_STAGE(PG8_SA(1, 0), a3, g20);
            PG8_WAIT_V(8); PG8_WAIT_L(0); PG8_BAR; PG8_MMA(1, 0, At, B0); PG8_MMA(1, 1, At, B1); PG8_BAR; PG8_SCHED;
            } else {
            PG8_LDB(B0, 0, 0); PG8_SCHED; PG8_LDA(At, 0, 0); PG8_STAGE(PG8_SA(1, 1), a1 + hstep, voffA);
            PG8_WAIT_L(8); PG8_BAR; PG8_WAIT_L(0); PG8_MMA(0, 0, At, B0); PG8_BAR; PG8_SCHED;
            PG8_LDB(B1, 0, 1); PG8_STAGE(PG8_SB(0, 0), b2, voffB);
            PG8_BAR; PG8_WAIT_L(0); PG8_MMA(0, 1, At, B1); PG8_BAR;
            PG8_LDA(At, 0, 1); PG8_STAGE(PG8_SA(0, 0), a2, voffA);
            PG8_BAR; PG8_WAIT_L(0); PG8_MMA(1, 0, At, B0); PG8_BAR; PG8_SCHED;
            PG8_STAGE(PG8_SB(0, 1), b2 + hstep, voffB);
            PG8_WAIT_V(6); PG8_BAR; PG8_MMA(1, 1, At, B1); PG8_BAR;
            PG8_LDB(B0, 1, 0); PG8_SCHED; PG8_LDA(At, 1, 0); PG8_STAGE(PG8_SA(0, 1), a2 + hstep, voffA);
            PG8_WAIT_L(8); PG8_BAR; PG8_WAIT_L(0); PG8_MMA(0, 0, At, B0); PG8_BAR; PG8_SCHED;
            PG8_LDB(B1, 1, 1); PG8_STAGE(PG8_SB(1, 0), b3, voffB);
            PG8_BAR; PG8_WAIT_L(0); PG8_MMA(0, 1, At, B1); PG8_BAR;
            PG8_LDA(At, 1, 1); PG8_STAGE(PG8_SA(1, 0), a3, voffA);
            PG8_BAR; PG8_WAIT_L(0); PG8_MMA(1, 0, At, B0); PG8_BAR; PG8_SCHED;
            PG8_STAGE(PG8_SB(1, 1), b3 + hstep, voffB);
            PG8_WAIT_V(6); PG8_BAR; PG8_MMA(1, 1, At, B1); PG8_BAR;
            }
        }
        if constexpr (ALIGN_EPI) { if (wr == 0) PG8_BAR; }
        if constexpr (!Epi::AFTER_DRAIN) { E(acc, cur, wr, wc, fr, fq); S.done(cur); }
        if (!has_next) break;
#pragma unroll
        for (int a = 0; a < 2; ++a)
#pragma unroll
            for (int b = 0; b < 2; ++b)
#pragma unroll
                for (int m = 0; m < 4; ++m)
#pragma unroll
                    for (int n = 0; n < 2; ++n) acc[a][b][m][n] = (f32x4){0.f, 0.f, 0.f, 0.f};
        cur = nxt; cB = nB; ++ui;
#pragma unroll
        for (int i = 0; i < 2; ++i) { gC0[i] = gN0[i]; gC1[i] = gN1[i]; }
        if constexpr (ALIGN_EPI) { if (wr == 1) PG8_BAR; }
    }
    PG8_WAIT_V(0);
    if constexpr (!ALIGN_EPI) { if (wr == 0) PG8_BAR; }
    PG8_BAR;
    if constexpr (Epi::AFTER_DRAIN) { E.fused(acc, cur, wr, wc, fr, fq, lds, wid, lane); S.done(cur); }
#undef PG8_SA
#undef PG8_SB
#undef PG8_STAGE
#undef PG8_LDA
#undef PG8_LDB
#undef PG8_MMA
#undef PG8_WAIT_V
#undef PG8_WAIT_L
#undef PG8_BAR
#undef PG8_SCHED
}
}

namespace att {
constexpr int D = 128; constexpr float THR = 8.f; constexpr bool WSKIP = false;
constexpr float SCALE = 0.08838834764831845f;
constexpr float RSCALE = 11.313708498984761f;
constexpr int LDQ = 3072, LDO = 2048;
constexpr int NW = 8, QBLK = 32, KVBLK = 64, QB = NW * QBLK;
constexpr int SHM_V = KVBLK * D * 2, SHM_K = KVBLK * D * 2;
constexpr int WS_OFF = 2 * SHM_V + 2 * SHM_K, WS_W = 768;
constexpr int LDS_BYTES = WS_OFF + NW * WS_W;

typedef unsigned short bf16;
typedef short bf16x8 __attribute__((ext_vector_type(8)));
typedef short s16x4 __attribute__((ext_vector_type(4)));
typedef float f32x16 __attribute__((ext_vector_type(16)));
typedef float f32x4 __attribute__((ext_vector_type(4)));
typedef unsigned u32x4 __attribute__((ext_vector_type(4)));
template <class A, class Bt> struct same_t { static constexpr bool v = false; };
template <class A> struct same_t<A, A> { static constexpr bool v = true; };

#define KSWZ(row, colB) ((row) * 256 + ((colB) ^ (((row) & 7) << 4)))
#define SBAR() __builtin_amdgcn_sched_barrier(0)
__device__ __forceinline__ int v_st(int k, int c) { const int kk = (k & ~0xC) | ((k & 4) << 1) | ((k & 8) >> 1); return ((kk >> 3) * 4 + (c >> 5)) * 512 + ((kk & 7) * 32 + (c & 31)) * 2; }
__device__ __forceinline__ int v_rd_base(int lane) { return ((lane & 3) << 3) | (((lane >> 2) & 3) << 6) | (((lane >> 4) & 1) << 5) | (((lane >> 5) & 1) << 8); }
constexpr int v_rd_off(int d0, int ks, int half) { return d0 * 512 + ks * 4096 + half * 2048; }
__device__ __forceinline__ int crow(int r, int hi) { return (r & 3) + 8 * (r >> 2) + 4 * hi; }
__device__ __forceinline__ unsigned cvtpk(float lo, float hi) {
    unsigned r; asm volatile("v_cvt_pk_bf16_f32 %0, %1, %2" : "=v"(r) : "v"(lo), "v"(hi)); return r;
}
__device__ __forceinline__ bf16x8 pack8(f32x4 a, f32x4 b) {
    u32x4 w = {cvtpk(a[0], a[1]), cvtpk(a[2], a[3]), cvtpk(b[0], b[1]), cvtpk(b[2], b[3])};
    return *reinterpret_cast<bf16x8*>(&w);
}
template <class T> __device__ __forceinline__ bf16x8 load8(const T* p) {
    if constexpr (same_t<T, float>::v) { return pack8(*(const f32x4*)p, *(const f32x4*)(p + 4)); }
    else { return *reinterpret_cast<const bf16x8*>(p); }
}
__device__ __forceinline__ void mask_tile(f32x16& p0, f32x16& p1, int dq, unsigned W) {
    const float NEG = -__builtin_inff();
#pragma unroll
    for (int r = 0; r < 16; ++r) {
        const int c = (r & 3) + 8 * (r >> 2);
        if ((unsigned)(dq - c) >= W) p0[r] = NEG;
        if ((unsigned)(dq - c - 32) >= W) p1[r] = NEG;
    }
}
__device__ __forceinline__ void partialSM(f32x16& p0, f32x16& p1, float& m_reg, float& mn, float& alpha) {
    float pmax = p0[0]; for (int r = 1; r < 16; ++r) pmax = fmaxf(pmax, p0[r]); for (int r = 0; r < 16; ++r) pmax = fmaxf(pmax, p1[r]);
    { auto rr = __builtin_amdgcn_permlane32_swap(__float_as_uint(pmax), __float_as_uint(pmax), false, false);
      pmax = fmaxf(__uint_as_float(rr[0]), __uint_as_float(rr[1])); }
    constexpr float C2 = 1.4426950408889634f * SCALE;
    if (__builtin_expect(__all((pmax - m_reg) * SCALE <= THR), 1)) { mn = m_reg; alpha = 1.f; }
    else { mn = fmaxf(m_reg, pmax); alpha = __builtin_amdgcn_exp2f((m_reg - mn) * C2); m_reg = mn; }
    const float mnL = -mn * C2;
    for (int r = 0; r < 16; ++r) p0[r] = fmaf(p0[r], C2, mnL); for (int r = 0; r < 16; ++r) p1[r] = fmaf(p1[r], C2, mnL);
    for (int r = 0; r < 16; ++r) p0[r] = __builtin_amdgcn_exp2f(p0[r]);
}
__device__ __forceinline__ void finishSM(f32x16& p0, f32x16& p1, float alpha, float& l_reg, bf16x8& pa0, bf16x8& pa1, bf16x8& pa2, bf16x8& pa3) {
    for (int r = 0; r < 16; ++r) p1[r] = __builtin_amdgcn_exp2f(p1[r]);
    float ps = 0; for (int r = 0; r < 16; ++r) ps += p0[r]; for (int r = 0; r < 16; ++r) ps += p1[r];
    { auto rr = __builtin_amdgcn_permlane32_swap(__float_as_uint(ps), __float_as_uint(ps), false, false);
      ps = __uint_as_float(rr[0]) + __uint_as_float(rr[1]); }
    l_reg = l_reg * alpha + ps;
#define PK4(P, B_, OUT) do { unsigned a0 = cvtpk(P[B_+0], P[B_+1]), a1 = cvtpk(P[B_+2], P[B_+3]);                          \
        unsigned b0 = cvtpk(P[B_+4], P[B_+5]), b1 = cvtpk(P[B_+6], P[B_+7]);                                             \
        auto r0 = __builtin_amdgcn_permlane32_swap(a0, b0, false, false); auto r1 = __builtin_amdgcn_permlane32_swap(a1, b1, false, false); \
        u32x4 w = {r0[0], r1[0], r0[1], r1[1]}; OUT = *reinterpret_cast<bf16x8*>(&w); } while (0)
    PK4(p0, 0, pa0); PK4(p0, 8, pa1); PK4(p1, 0, pa2); PK4(p1, 8, pa3);
#undef PK4
}
template <int KB, bool SK>
__device__ __forceinline__ void qkt(f32x16& p0, f32x16& p1, const char* K_lds, int r32, int hi, const bf16x8* qr, bool act, const float* cbl) {
    if (SK && !act) { const float NEG = -__builtin_inff();
#pragma unroll
        for (int r = 0; r < 16; ++r) { p0[r] = NEG; p1[r] = NEG; } return; }
#pragma unroll
    for (int g_ = 0; g_ < 4; ++g_) { const f32x4 b0_ = *(const f32x4*)(cbl + KB * 64 + 8 * g_), b1_ = *(const f32x4*)(cbl + KB * 64 + 32 + 8 * g_);
#pragma unroll
        for (int e_ = 0; e_ < 4; ++e_) { p0[4 * g_ + e_] = b0_[e_]; p1[4 * g_ + e_] = b1_[e_]; } }
    const char* kb[4];
#pragma unroll
    for (int dd = 0; dd < 4; ++dd) kb[dd] = K_lds + KB * SHM_K + KSWZ(r32, (dd * 16 + hi * 8) * 2);
#pragma unroll
    for (int d0 = 0; d0 < 8; ++d0) { const char* a = kb[d0 & 3] + (d0 >> 2) * 128;
        bf16x8 b0 = *reinterpret_cast<const bf16x8*>(a);
        bf16x8 b1 = *reinterpret_cast<const bf16x8*>(a + 32 * 256);
        p0 = __builtin_amdgcn_mfma_f32_32x32x16_bf16(b0, qr[d0], p0, 0, 0, 0);
        p1 = __builtin_amdgcn_mfma_f32_32x32x16_bf16(b1, qr[d0], p1, 0, 0, 0); }
}
template <int VB, bool SK>
__device__ __forceinline__ void pv_tile(f32x16* o, int vb0, bf16x8 pa0, bf16x8 pa1, bf16x8 pa2, bf16x8 pa3, bool act) {
    if (SK && !act) return;
#define TRRD(dst, off) asm volatile("ds_read_b64_tr_b16 %0, %1 offset:%2" : "=&v"(dst) : "v"(vb0), "i"(off) : "memory")
#define PV_D0(d0) do { s16x4 l0, l1, l2, l3, h0, h1, h2, h3; constexpr int b_ = VB * SHM_V + v_rd_off(d0, 0, 0);     \
        TRRD(l0, b_); TRRD(h0, b_ + 2048); TRRD(l1, b_ + 4096); TRRD(h1, b_ + 6144); TRRD(l2, b_ + 8192); TRRD(h2, b_ + 10240); TRRD(l3, b_ + 12288); TRRD(h3, b_ + 14336); \
        asm volatile("s_waitcnt lgkmcnt(0)" ::: "memory"); SBAR();                 \
        o[d0] = __builtin_amdgcn_mfma_f32_32x32x16_bf16(pa0, (bf16x8){l0[0], l0[1], l0[2], l0[3], h0[0], h0[1], h0[2], h0[3]}, o[d0], 0, 0, 0);   \
        o[d0] = __builtin_amdgcn_mfma_f32_32x32x16_bf16(pa1, (bf16x8){l1[0], l1[1], l1[2], l1[3], h1[0], h1[1], h1[2], h1[3]}, o[d0], 0, 0, 0);   \
        o[d0] = __builtin_amdgcn_mfma_f32_32x32x16_bf16(pa2, (bf16x8){l2[0], l2[1], l2[2], l2[3], h2[0], h2[1], h2[2], h2[3]}, o[d0], 0, 0, 0);   \
        o[d0] = __builtin_amdgcn_mfma_f32_32x32x16_bf16(pa3, (bf16x8){l3[0], l3[1], l3[2], l3[3], h3[0], h3[1], h3[2], h3[3]}, o[d0], 0, 0, 0); } while (0)
    PV_D0(0); PV_D0(1); PV_D0(2); PV_D0(3);
#undef PV_D0
#undef TRRD
}

template <class TIn, class TOut> struct BlockRef { const TIn* Q; const TIn* K; const TIn* V; TOut* O; const float* C; int P0; };
template <class TIn> struct Seam {
    bf16x8 qr[8];
    bf16x8 st_v0, st_v1, st_k0, st_k1; f32x4 sf0, sf1, sf2, sf3;
    f32x4 tq[16];
};
__device__ __forceinline__ int swa_jlo(int P0, int W) { const int lowk = P0 - W + 1; return lowk > 0 ? lowk / KVBLK : 0; }
#define ROW(p, k0, rr) ((p) + (size_t)((k0) + (rr)) * LDQ + sc)
#define UROW(p, k0) ((const char*)(p) + (size_t)(k0) * (LDQ * 2))
#define LD16(ub, vo) (*(const bf16x8*)((ub) + (vo)))
#define CDMA(Cp, k0, bf) __builtin_amdgcn_global_load_lds((const unsigned*)((const char*)((Cp) + (k0)) + lane4), (__attribute__((address_space(3))) unsigned*)(lds + WS_OFF + wid * WS_W + 256 + (bf) * 256), 4, 0, 0)
#define VMW() asm volatile("s_waitcnt vmcnt(0)" ::: "memory")
#define VMWN(n) asm volatile("s_waitcnt vmcnt(%0)" :: "i"(n) : "memory")
#define SLOAD_H(Kp, Vp, k0, Cp, bf) do { S.st_v0 = LD16(UROW(Vp, k0), toff); S.st_v1 = LD16(UROW(Vp, (k0) + 32), toff);              \
                         S.st_k0 = LD16(UROW(Kp, k0), toff); S.st_k1 = LD16(UROW(Kp, (k0) + 32), toff); } while (0)
#define SWRITE_HK(bf) do { *(bf16x8*)(K_lds + (bf) * SHM_K + kws) = S.st_k0; *(bf16x8*)(K_lds + (bf) * SHM_K + kws + 32 * 256) = S.st_k1; } while (0)
#define SWRITE_HV(bf) do { *(bf16x8*)(V_lds + (bf) * SHM_V + vst0) = S.st_v0; *(bf16x8*)(V_lds + (bf) * SHM_V + vst1) = S.st_v1; } while (0)
#define SWRITE_H(bf) do { SWRITE_HV(bf); SWRITE_HK(bf); } while (0)
#define SLOAD_F(p, k0) do { S.sf0 = *(const f32x4*)ROW(p, k0, sr); S.sf1 = *(const f32x4*)(ROW(p, k0, sr) + 4);                \
                            S.sf2 = *(const f32x4*)ROW(p, k0, 32 + sr); S.sf3 = *(const f32x4*)(ROW(p, k0, 32 + sr) + 4); } while (0)
#define SWRITE_KF(bf) do { *(bf16x8*)(K_lds + (bf) * SHM_K + kws) = pack8(S.sf0, S.sf1); *(bf16x8*)(K_lds + (bf) * SHM_K + kws + 32 * 256) = pack8(S.sf2, S.sf3); } while (0)
#define SWRITE_VF(bf) do { *(bf16x8*)(V_lds + (bf) * SHM_V + vst0) = pack8(S.sf0, S.sf1); *(bf16x8*)(V_lds + (bf) * SHM_V + vst1) = pack8(S.sf2, S.sf3); } while (0)
template <class TIn, class TOut>
__device__ __forceinline__ void causal_swa_prime(const BlockRef<TIn, TOut>& cur, int W, char* lds, Seam<TIn>& S) {
    constexpr bool F32 = same_t<TIn, float>::v;
    const int tid = threadIdx.x, wid = __builtin_amdgcn_readfirstlane(tid >> 6), lane = tid & 63, r32 = lane & 31, hi = lane >> 5;
    const int sr = tid >> 4, sc = (tid & 15) * 8, kws = KSWZ(sr, sc * 2); char* K_lds = lds + 2 * SHM_V; const unsigned toff = (unsigned)(sr * LDQ + sc) * 2u, qoff = (unsigned)(r32 * LDQ + hi * 8) * 2u;
    const int kb0 = swa_jlo(cur.P0, W) * KVBLK;
    for (int d0 = 0; d0 < 8; ++d0) S.qr[d0] = LD16((const char*)(cur.Q + (size_t)(wid * QBLK) * LDQ + d0 * 16), qoff);
    if constexpr (F32) { SLOAD_F((const float*)cur.K, kb0); VMW(); SWRITE_KF(0); SBAR(); SLOAD_F((const float*)cur.V, kb0); }
    else { const unsigned lane4 = (unsigned)lane * 4u; SLOAD_H(cur.K, cur.V, kb0, cur.C, 0); CDMA(cur.C, kb0, 0); VMW(); SWRITE_HK(0); }
    __syncthreads();
}
template <class TIn, class TOut>
__device__ __forceinline__ void causal_swa_block(const BlockRef<TIn, TOut>& cur, const BlockRef<TIn, TOut>& nxt, int skv, int W, char* lds, Seam<TIn>& S) {
    constexpr bool F32 = same_t<TIn, float>::v;
    const int tid = threadIdx.x, wid = __builtin_amdgcn_readfirstlane(tid >> 6), lane = tid & 63, r32 = lane & 31, hi = lane >> 5;
    const int j_lo = swa_jlo(cur.P0, W);
    int j_hi = (cur.P0 + QB - 1) / KVBLK + 1; if (j_hi > skv / KVBLK) j_hi = skv / KVBLK;
    const int NT = j_hi - j_lo;
    const int kbn = swa_jlo(nxt.P0, W) * KVBLK;
    const int qlo = cur.P0 + wid * QBLK, qm = qlo + r32 - 4 * hi;
    char* V_lds = lds; char* K_lds = lds + 2 * SHM_V;
    const unsigned lane4 = (unsigned)lane * 4u;
    float* ws = (float*)(lds + WS_OFF + wid * WS_W); float* li_l = ws, * al_l = ws + 32;
    const float* cbl = al_l + 32 + 4 * hi;
    float m_reg = -1e30f, l_reg = 0; f32x16 o[4] = {};
    const unsigned toff = (unsigned)((tid >> 4) * LDQ + (tid & 15) * 8) * 2u, qoff = (unsigned)(r32 * LDQ + hi * 8) * 2u;
    const int sr = tid >> 4, sc = (tid & 15) * 8, vst0 = v_st(sr, sc), vst1 = vst0 + 8192  , kws = KSWZ(sr, sc * 2);
    const int vb0 = (int)(uintptr_t)V_lds + v_rd_base(lane);
    const TIn* Kh = cur.K; const TIn* Vh = cur.V;
#define RESC(a) do { if (__any((a) < 1.f)) { if (hi == 0) al_l[r32] = (a); asm volatile("s_waitcnt lgkmcnt(0)" ::: "memory");              \
                     for (int d_ = 0; d_ < 4; ++d_) for (int r = 0; r < 16; ++r) o[d_][r] *= al_l[crow(r, hi)]; } } while (0)
#define KBASE(t) ((j_lo + (t)) * KVBLK)
#define ACT(t) (KBASE(t) <= qlo + QBLK - 1 && KBASE(t) + KVBLK - 1 >= qlo - W + 1)
#define MASKT(P0_, P1_, t) do { const int kb_ = KBASE(t); if ((!SK || ACT(t)) && (kb_ + KVBLK - 1 > qlo || kb_ <= qlo + QBLK - 1 - W)) mask_tile(P0_, P1_, qm - kb_, (unsigned)W); } while (0)
    constexpr int NQL = F32 ? 16 : 8;
    constexpr bool SK = WSKIP && !F32;
#define SEAM_K0() do { VMWN(NQL); if constexpr (F32) { SWRITE_KF(0); SBAR(); SLOAD_F((const float*)nxt.V, kbn); } else { SWRITE_HK(0); } SBAR(); } while (0)
    f32x16 pA0, pA1, pB0, pB1; float mnA, mnB, alA, alB; bf16x8 pa0, pa1, pa2, pa3;
    if constexpr (F32) { VMW(); SWRITE_VF(0); SBAR(); } else { SWRITE_HV(0); SBAR(); }
    if (NT > 1) { if constexpr (F32) SLOAD_F((const float*)Kh, KBASE(1)); else { CDMA(cur.C, KBASE(1), 1); SLOAD_H(Kh, Vh, KBASE(1), cur.C, 1); } }
    SBAR(); qkt<0, SK>(pA0, pA1, K_lds, r32, hi, S.qr, ACT(0), cbl);
    if constexpr (F32) { if (NT > 1) { VMW(); SWRITE_KF(1); SBAR(); SLOAD_F((const float*)Vh, KBASE(1)); } }
    MASKT(pA0, pA1, 0); partialSM(pA0, pA1, m_reg, mnA, alA);
    if (NT > 1) { VMW(); if constexpr (F32) { SWRITE_VF(1); SBAR(); if (NT > 2) SLOAD_F((const float*)Kh, KBASE(2)); } else SWRITE_H(1); }
    __syncthreads();
#define HALF_STEP(PX0, PX1, mnX, alX, PY0, PY1, alY, t, KB, VB, SB) do {                                                      \
        if ((t) + 1 < NT) CDMA(cur.C, KBASE((t) + 1), SB);                                                                   \
        SBAR(); qkt<KB, SK>(PX0, PX1, K_lds, r32, hi, S.qr, ACT(t), cbl);                                             \
        finishSM(PY0, PY1, alY, l_reg, pa0, pa1, pa2, pa3); SBAR();                                                           \
        if ((t) + 1 < NT) { if constexpr (F32) { VMW(); SWRITE_KF(SB); SBAR(); SLOAD_F((const float*)Vh, KBASE((t) + 1)); }  \
                            else { SLOAD_H(Kh, Vh, KBASE((t) + 1), cur.C, SB); } SBAR(); }                                               \
        pv_tile<VB, SK>(o, vb0, pa0, pa1, pa2, pa3, ACT((t) - 1)); MASKT(PX0, PX1, (t)); partialSM(PX0, PX1, m_reg, mnX, alX);                                        \
        __syncthreads();                                                                                                      \
        if ((t) + 1 < NT) { VMW(); if constexpr (F32) { SWRITE_VF(SB); SBAR(); if ((t) + 2 < NT) SLOAD_F((const float*)Kh, KBASE((t) + 2)); } \
                            else { SWRITE_H(SB); } }                                                                          \
        RESC(alX); __syncthreads(); } while (0)
    for (int t = 1; t + 1 < NT; t += 2) {
        HALF_STEP(pB0, pB1, mnB, alB, pA0, pA1, alA, t, 1, 0, 0);
        HALF_STEP(pA0, pA1, mnA, alA, pB0, pB1, alB, t + 1, 0, 1, 1);
    }
    const bool even = (NT & 1) == 0;
    if (even) { SBAR(); qkt<1, SK>(pB0, pB1, K_lds, r32, hi, S.qr, ACT(NT - 1), cbl); SBAR(); }
#define QROW(e) (nxt.Q + (size_t)(wid * QBLK + r32) * D + ((e) >> 1) * 16 + hi * 8 + ((e) & 1) * 4)
    if constexpr (F32) { SLOAD_F((const float*)nxt.K, kbn); SBAR();
#pragma unroll
        for (int e = 0; e < 8; ++e) S.tq[e] = *(const f32x4*)QROW(e); }
    else { SLOAD_H(nxt.K, nxt.V, kbn, nxt.C, 0); CDMA(nxt.C, kbn, 0); SBAR();
#pragma unroll
        for (int d0 = 0; d0 < 8; ++d0) S.qr[d0] = LD16((const char*)(nxt.Q + (size_t)(wid * QBLK) * LDQ + d0 * 16), qoff); }
    SBAR();
    finishSM(pA0, pA1, alA, l_reg, pa0, pa1, pa2, pa3); SBAR();
    if constexpr (F32) {
#pragma unroll
        for (int e = 8; e < 16; ++e) S.tq[e] = *(const f32x4*)QROW(e); SBAR(); }
#undef QROW
    pv_tile<0, SK>(o, vb0, pa0, pa1, pa2, pa3, ACT(even ? NT - 2 : NT - 1));
    if (even) { MASKT(pB0, pB1, NT - 1); partialSM(pB0, pB1, m_reg, mnB, alB); __syncthreads(); RESC(alB);
        finishSM(pB0, pB1, alB, l_reg, pa0, pa1, pa2, pa3); SBAR(); pv_tile<1, SK>(o, vb0, pa0, pa1, pa2, pa3, ACT(NT - 1)); }
    SBAR(); SEAM_K0();
    if (hi == 0) li_l[r32] = l_reg; asm volatile("s_waitcnt lgkmcnt(0)" ::: "memory");
    float rli[16];
#pragma unroll
    for (int r = 0; r < 16; ++r) rli[r] = __builtin_amdgcn_rcpf(li_l[crow(r, hi)]);
    TOut* Ow = cur.O + (size_t)(wid * QBLK) * LDO;
#pragma unroll
    for (int r = 0; r < 16; ++r) { const int orow = crow(r, hi);
#pragma unroll
        for (int d0 = 0; d0 < 4; ++d0) { const float v = o[d0][r] * rli[r];
            if constexpr (same_t<TOut, float>::v) { Ow[(size_t)orow * LDO + d0 * 32 + r32] = v; }
            else { const float vn = __shfl_xor(v, 1);
                   if ((r32 & 1) == 0) *(unsigned*)(Ow + (size_t)orow * LDO + d0 * 32 + r32) = cvtpk(v, vn); } } }
    if constexpr (F32) {
#pragma unroll
        for (int d0 = 0; d0 < 8; ++d0) S.qr[d0] = pack8(S.tq[2 * d0], S.tq[2 * d0 + 1]); }
    __syncthreads();
#undef RESC
#undef KBASE
#undef ACT
#undef MASKT
#undef SEAM_K0
#undef HALF_STEP
}
#undef ROW
#undef VMW
#undef VMWN
#undef SLOAD_H
#undef SWRITE_HK
#undef SWRITE_HV
#undef SWRITE_H
#undef SLOAD_F
#undef SWRITE_KF
#undef SWRITE_VF

}

#define LAS __attribute__((address_space(3)))
typedef unsigned short bf16;
typedef float f32x4 __attribute__((ext_vector_type(4)));
typedef float f32x2 __attribute__((ext_vector_type(2)));
typedef unsigned u32x4 __attribute__((ext_vector_type(4)));
typedef unsigned u32x2 __attribute__((ext_vector_type(2)));
typedef __bf16 bf16x2_t __attribute__((ext_vector_type(2)));

constexpr int DM = 2048, NBATCH = 2, SEQ = 8192, NMETA = 16, T = SEQ + NMETA  , TP = 8448  ;
constexpr int MROWS = NBATCH * TP  , NTOK = NBATCH * T;
constexpr int LDZ0 = 3072, LDZ1 = 6144;
constexpr int NEXP = 32, DEXP = 512, NBLK_MAX = 161, RMAX = NBLK_MAX * 256;
constexpr int NCHUNK = 129, NCH = 2 * 8 * NCHUNK  ;
constexpr float EPS = 1e-6f;
constexpr int NWAVES = 8, NTHR = 512;

constexpr size_t MiB = 1u << 20;
constexpr size_t WS_CTL = 0;
constexpr size_t WS_READY = 32 * 1024;
constexpr size_t WS_BAR = 64 * 1024;
constexpr size_t WS_TOKINFO = 1 * MiB;
constexpr size_t WS_ROWTOK = 1 * MiB + 640 * 1024;
constexpr size_t WS_LOGF = 2 * MiB;
constexpr size_t WS_CB = 3 * MiB;
constexpr size_t WS_GB = 4 * MiB;
constexpr size_t WS_BB = 5 * MiB;
constexpr size_t WS_XW = 6 * MiB;
constexpr size_t WS_LRUA = 7 * MiB, WS_LRUB = 8 * MiB + 512 * 1024, WS_LRUC = 10 * MiB;
constexpr size_t WS_WGBASE = 15 * MiB;
constexpr size_t WS_DUMP = 14 * MiB;
constexpr size_t WS_GT = 12 * MiB;
constexpr size_t WS_LRUW = 13 * MiB;
constexpr size_t WS_W0IN = 16 * MiB, WS_W0OUT = 36 * MiB, WS_W1IN = 44 * MiB, WS_W1OUT = 68 * MiB;
constexpr size_t WS_WGU = 80 * MiB, WS_WD = 208 * MiB;
constexpr size_t WS_H = 272 * MiB;
constexpr size_t WS_HN = 404 * MiB;
constexpr size_t WS_A2 = 470 * MiB;
constexpr size_t WS_Z = 536 * MiB;
constexpr size_t WS_U = 636 * MiB;
constexpr size_t WS_XS = 734 * MiB;
constexpr size_t WS_HID = 895 * MiB;
constexpr size_t WS_GU = 734 * MiB, WS_GW = 767 * MiB, WS_GQD = 800 * MiB, WS_GKD = 833 * MiB, WS_GATT = 866 * MiB;
constexpr size_t WS_O = 883 * MiB;
constexpr size_t WS_HL = 949 * MiB, WS_PP = 982 * MiB;
constexpr size_t WS_END = 1015 * MiB;

constexpr int LDS_BYTES = 155648;
constexpr int MISC_OFF = 131072 + 16384;

struct TokInfo { int e1, e2; float w1, w2; int pos1, pos2, s1, s2; };

struct Params { const float* in[32]; float* out; unsigned char* ws; int ph_lo, ph_hi; };

#define LBAR() do { asm volatile("s_waitcnt lgkmcnt(0)" ::: "memory"); __builtin_amdgcn_s_barrier(); asm volatile("" ::: "memory"); } while (0)
__device__ __forceinline__ unsigned pk2(float lo, float hi) { const f32x2 v = {lo, hi}; return __builtin_bit_cast(unsigned, __builtin_convertvector(v, bf16x2_t)); }
__device__ __forceinline__ unsigned f2bf(float f) { return pk2(f, f) & 0xffffu; }
__device__ __forceinline__ float bf2f(unsigned short b) { return __builtin_bit_cast(float, (unsigned)b << 16); }
__device__ __forceinline__ float bflo(unsigned w) { return __builtin_bit_cast(float, w << 16); }
__device__ __forceinline__ float bfhi(unsigned w) { return __builtin_bit_cast(float, w & 0xffff0000u); }
__device__ __forceinline__ float dot2bf(unsigned a, unsigned b, float c) { asm volatile("" : "+v"(a), "+v"(b)); return __builtin_amdgcn_fdot2_f32_bf16(__builtin_bit_cast(bf16x2_t, a), __builtin_bit_cast(bf16x2_t, b), c, false); }
#define DPPF(v, ctrl, rowmask) __builtin_bit_cast(float, __builtin_amdgcn_update_dpp(0, __builtin_bit_cast(int, (v)), (ctrl), (rowmask), 0xf, false))
__device__ __forceinline__ float row16_sum(float v) { v += DPPF(v, 0xB1, 0xf); v += DPPF(v, 0x4E, 0xf); v += DPPF(v, 0x141, 0xf); v += DPPF(v, 0x140, 0xf); return v; }
__device__ __forceinline__ float wave_sum(float v) {
    v = row16_sum(v);
    v += DPPF(v, 0x142, 0xa); v += DPPF(v, 0x143, 0xc);
    return __builtin_bit_cast(float, __builtin_amdgcn_readlane(__builtin_bit_cast(int, v), 63));
}
__device__ __forceinline__ float sigmoidf_(float x) { return __builtin_amdgcn_rcpf(1.0f + __expf(-x)); }
__device__ __forceinline__ float siluf_(float x) { return x * __builtin_amdgcn_rcpf(1.0f + __expf(-x)); }
__device__ __forceinline__ float softplusf_(float x) { return fmaxf(x, 0.f) + log1pf(__expf(-fabsf(x))); }
__device__ __forceinline__ float geluf_tanh(float x) { const float u = 0.7978845608028654f * (x + 0.044715f * x * x * x); return x * __builtin_amdgcn_rcpf(1.0f + __expf(-2.0f * u)); }

struct TrDesc { const float* src; bf16* dst; int ldw, K, scol, drow, k0; };
__device__ __forceinline__ void tr_load(const TrDesc& d, f32x4 (&v)[16], int lane) {
    const float* s = d.src + (size_t)(d.k0 + (lane >> 4)) * d.ldw + d.scol + 4 * (lane & 15);
#pragma unroll
    for (int i = 0; i < 16; ++i) v[i] = __builtin_nontemporal_load((const f32x4*)(s + (size_t)(4 * i) * d.ldw));
}
__device__ __forceinline__ void tr_store(const TrDesc& d, const f32x4 (&v)[16], LAS float* scr, int lane) {
#pragma unroll
    for (int i = 0; i < 16; ++i) { LAS float* q = scr + (4 * i + (lane >> 4)) * 65 + 4 * (lane & 15); q[0] = v[i][0]; q[1] = v[i][1]; q[2] = v[i][2]; q[3] = v[i][3]; }
    asm volatile("s_waitcnt lgkmcnt(0)" ::: "memory");
    const int c = lane & 7;
#pragma unroll
    for (int j = 0; j < 8; ++j) { const int n = (lane >> 3) + 8 * j; const LAS float* s = scr + (8 * c) * 65 + n;
        u32x4 o; o.x = pk2(s[0 * 65], s[1 * 65]); o.y = pk2(s[2 * 65], s[3 * 65]); o.z = pk2(s[4 * 65], s[5 * 65]); o.w = pk2(s[6 * 65], s[7 * 65]);
        __builtin_nontemporal_store(o, (u32x4*)(d.dst + (size_t)(d.drow + n) * d.K + d.k0 + 8 * c)); }
    asm volatile("s_waitcnt lgkmcnt(0)" ::: "memory");
}
constexpr int N_DENSE_ITEMS = 32 * (48 + 32 + 32 + 48 + 48 + 32);
constexpr int N_MOE_ITEMS = NEXP * 768;
__device__ __forceinline__ TrDesc tr_decode(const Params& p, int layer, int ndense, int it) {
    unsigned char* ws = p.ws; TrDesc d;
    if (it < ndense) { int r = it; int scol0, nblk, drow0; d.K = 2048;
        if (r < 32 * 48) { d.src = p.in[5]; d.ldw = 5128; scol0 = 0; nblk = 48; d.dst = (bf16*)(ws + WS_W0IN); drow0 = 0; }
        else if ((r -= 32 * 48) < 32 * 32) { d.src = p.in[5]; d.ldw = 5128; scol0 = 3080; nblk = 32; d.dst = (bf16*)(ws + WS_W0IN); drow0 = -1; }
        else if ((r -= 32 * 32) < 32 * 32) { d.src = p.in[11]; d.ldw = 2048; scol0 = 0; nblk = 32; d.dst = (bf16*)(ws + WS_W0OUT); drow0 = 0; }
        else if ((r -= 32 * 32) < 32 * 48) { d.src = p.in[12]; d.ldw = 6160; scol0 = 0; nblk = 48; d.dst = (bf16*)(ws + WS_W1IN); drow0 = 0; }
        else if ((r -= 32 * 48) < 32 * 48) { d.src = p.in[12]; d.ldw = 6160; scol0 = 3088; nblk = 48; d.dst = (bf16*)(ws + WS_W1IN); drow0 = 3072; }
        else { r -= 32 * 48; d.src = p.in[24]; d.ldw = 2048; scol0 = 0; nblk = 32; d.dst = (bf16*)(ws + WS_W1OUT); drow0 = 0; }
        const int kb = r / nblk, nb = r - kb * nblk; d.k0 = 64 * kb; d.scol = scol0 + 64 * nb; d.drow = drow0 + 64 * nb;
        if (drow0 < 0) { const int sc = 64 * nb, isb = sc >= 1024, c = sc - 1024 * isb; d.drow = 3072 + (c >> 7) * 256 + isb * 128 + (c & 127); }
    } else { it -= ndense; const int e = it / 768; int r = it - e * 768; const size_t le = (size_t)layer * NEXP + e;
        if (r < 512) {
            const int up = r >= 256; r -= up * 256; const int kb = r / 8, nb = r - kb * 8, col = 64 * nb;
            d.src = (up ? p.in[30] : p.in[29]) + le * (size_t)(2048 * 512); d.ldw = 512; d.K = 2048; d.scol = col; d.k0 = 64 * kb;
            d.dst = (bf16*)(ws + WS_WGU) + (size_t)e * (1024 * 2048); d.drow = (col >> 7) * 256 + up * 128 + (col & 127);
        } else {
            r -= 512; const int kb = r / 32, nb = r - kb * 32;
            d.src = p.in[31] + le * (size_t)(512 * 2048); d.ldw = 2048; d.K = 512; d.scol = 64 * nb; d.k0 = 64 * kb;
            d.dst = (bf16*)(ws + WS_WD) + (size_t)e * (2048 * 512); d.drow = 64 * nb; } }
    return d;
}
__device__ __forceinline__ void convert_weights_sub(const Params& p, LAS unsigned char* lds, int layer, int ndense, int nmoe, int bi, int nb) {
    const int tid = threadIdx.x, lane = tid & 63, wave = __builtin_amdgcn_readfirstlane(tid >> 6);
    const int gw = bi * NWAVES + wave, NGW = nb * NWAVES, total = ndense + nmoe;
    LAS float* scr = (LAS float*)(lds + wave * 16640);
    f32x4 va[16], vb[16];
    int it = gw; if (it >= total) return;
    TrDesc da = tr_decode(p, layer, ndense, it), db = da; tr_load(da, va, lane);
    for (;;) {
        const int i1 = it + NGW; if (i1 < total) { db = tr_decode(p, layer, ndense, i1); tr_load(db, vb, lane); }
        tr_store(da, va, scr, lane); if (i1 >= total) break;
        const int i2 = i1 + NGW; if (i2 < total) { da = tr_decode(p, layer, ndense, i2); tr_load(da, va, lane); }
        tr_store(db, vb, scr, lane); if (i2 >= total) break;
        it = i2;
    }
}
__device__ __forceinline__ void convert_weights(const Params& p, LAS unsigned char* lds, int layer, int ndense, int nmoe) { convert_weights_sub(p, lds, layer, ndense, nmoe, blockIdx.x, gridDim.x); }

__device__ __forceinline__ void conv_extras(const Params& p, int gtid, int gthreads) {
    bf16* xw = (bf16*)(p.ws + WS_XW);
    for (int i = gtid; i < 8 * 2048; i += gthreads) { const int c = i >> 11, k = i & 2047; xw[i] = (bf16)f2bf(p.in[5][(size_t)k * 5128 + 3072 + c]); }
    for (int i = gtid; i < 16 * 2048; i += gthreads) { const int c = i >> 11, k = i & 2047; xw[32768 + i] = (bf16)f2bf(p.in[12][(size_t)k * 6160 + 3072 + c]); }
    { bf16* lw = (bf16*)(p.ws + WS_LRUW);
      for (int i = gtid; i < 2 * 8 * 16384; i += gthreads) { const int g = i >> 17, blk = (i >> 14) & 7, o = (i >> 7) & 127, c = i & 127; lw[i] = (bf16)f2bf((g ? p.in[21] : p.in[19])[(size_t)blk * 16384 + c * 128 + o]); } }
    for (int l = 0; l < 2; ++l) {
        bf16* wr = xw + 65536 + l * (96 * 1024);
        for (int i = gtid; i < 36 * 2048; i += gthreads) { const int c = i >> 11, k = i & 2047;
            const float v = c < 4 ? p.in[25][(size_t)l * 2048 * 4 + k * 4 + c] : p.in[27][(size_t)l * 2048 * 32 + k * 32 + (c - 4)];
            wr[i] = (bf16)f2bf(v); }
    }
}

template <int MODE, int ABL = 0> __device__ __forceinline__ void norm_phase(const Params& p, LAS unsigned char* lds, int layer) {
    const int tid = threadIdx.x, lane = tid & 63, wave = __builtin_amdgcn_readfirstlane(tid >> 6);
    unsigned char* ws = p.ws;
    constexpr int NCOL = MODE == 0 ? 8 : MODE == 1 ? 36 : MODE == 2 ? 16 : 0;
    if (MODE == 0) {
        { float tv[32];
#pragma unroll
          for (int it = 0; it < 32; ++it) { const int i = tid + NTHR * it, k = i >> 3, c = i & 7; tv[it] = p.in[5][(size_t)k * 5128 + 3072 + c]; }
#pragma unroll
          for (int it = 0; it < 32; ++it) { const int i = tid + NTHR * it, k = i >> 3, c = i & 7; ((LAS bf16*)lds)[c * 2048 + k] = (bf16)f2bf(tv[it]); } }
        if (tid < 8) ((LAS float*)(lds + MISC_OFF + 1024))[tid] = p.in[6][tid];
        __syncthreads();
    } else if (NCOL) {
        const bf16* src = (const bf16*)(ws + WS_XW) + (MODE == 2 ? 32768 : 65536 + layer * (96 * 1024));
        { constexpr int NIT = NCOL * 2048 / 8 / NTHR; static_assert(NIT * NTHR * 8 == NCOL * 2048, "extras staging"); u32x4 tv[NIT ? NIT : 1];
#pragma unroll
          for (int it = 0; it < NIT; ++it) tv[it] = ((const u32x4*)src)[tid + NTHR * it];
#pragma unroll
          for (int it = 0; it < NIT; ++it) ((LAS u32x4*)lds)[tid + NTHR * it] = tv[it]; }
        if (MODE == 1 && tid < 64) ((LAS unsigned*)(lds + MISC_OFF))[tid] = 0u;
        if (MODE == 1 && tid < 36) ((LAS float*)(lds + MISC_OFF + 1024))[tid] = tid < 4 ? p.in[26][layer * 4 + tid] : p.in[28][layer * NEXP + tid - 4];
        if (MODE == 2 && tid < 16) ((LAS float*)(lds + MISC_OFF + 1024))[tid] = tid < 8 ? p.in[14][tid] : p.in[15][tid - 8];
        __syncthreads();
    }
    bf16* h = (bf16*)(ws + WS_H); bf16* hn = (bf16*)(ws + WS_HN);
    const float* gain = MODE == 0 || MODE == 2 ? p.in[2] + layer * DM : MODE == 1 ? p.in[3] + layer * DM : p.in[4];
    f32x4 g4[8];
#pragma unroll
    for (int j = 0; j < 8; ++j) g4[j] = ((const f32x4*)gain)[128 * (j >> 1) + 2 * lane + (j & 1)];
    const int gw = blockIdx.x * NWAVES + wave, NGW = gridDim.x * NWAVES;
    constexpr bool COMB = (MODE == 2 || MODE == 3) && !(ABL & 1);
    const TokInfo* tinfo = (const TokInfo*)(ws + WS_TOKINFO); const bf16* yb = (const bf16*)(ws + WS_XS);
    auto rowof = [&](int tok) -> size_t { const int b = tok / T; return (size_t)b * TP + (tok - b * T); };
    auto issue_h = [&](int tok, f32x4 (&v)[8]) { const int b = tok / T, t = tok - b * T;
        if (MODE == 0) { const float* src = t < NMETA ? p.in[1] + (size_t)t * DM : p.in[0] + ((size_t)b * SEQ + (t - NMETA)) * DM;
#pragma unroll
            for (int j = 0; j < 8; ++j) v[j] = ((const f32x4*)src)[128 * (j >> 1) + 2 * lane + (j & 1)]; }
        else { const u32x4* src = (const u32x4*)(h + ((size_t)b * TP + t) * DM);
#pragma unroll
            for (int jj = 0; jj < 4; ++jj) { const u32x4 w = src[lane + 64 * jj]; v[2 * jj] = (f32x4){bflo(w.x), bfhi(w.x), bflo(w.y), bfhi(w.y)}; v[2 * jj + 1] = (f32x4){bflo(w.z), bfhi(w.z), bflo(w.w), bfhi(w.w)}; } } };
    auto issue_y = [&](const TokInfo& ti, u32x4 (&a)[4], u32x4 (&c)[4]) { const u32x4* y1 = (const u32x4*)(yb + (size_t)ti.s1 * DM); const u32x4* y2 = (const u32x4*)(yb + (size_t)ti.s2 * DM);
#pragma unroll
        for (int jj = 0; jj < 4; ++jj) { a[jj] = y1[lane + 64 * jj]; c[jj] = y2[lane + 64 * jj]; } };
    f32x4 v[8], vn[8]; u32x4 ya[4], yc[4], yan[4], ycn[4], hb[4]; TokInfo ti{}, tin{}, tin2{};
    u32x4 hrA[4], hrB[4];
    auto issue_hr = [&](int tok, u32x4 (&r)[4]) { const int b = tok / T, t = tok - b * T; const u32x4* src = (const u32x4*)(h + ((size_t)b * TP + t) * DM);
#pragma unroll
        for (int jj = 0; jj < 4; ++jj) r[jj] = src[lane + 64 * jj]; };
    auto cvt_hr = [&](const u32x4 (&r)[4]) {
#pragma unroll
        for (int jj = 0; jj < 4; ++jj) { const u32x4 w = r[jj]; v[2 * jj] = (f32x4){bflo(w.x), bfhi(w.x), bflo(w.y), bfhi(w.y)}; v[2 * jj + 1] = (f32x4){bflo(w.z), bfhi(w.z), bflo(w.w), bfhi(w.w)}; } };
    if (gw < NTOK) {
        if (MODE == 1) { issue_hr(gw, hrA); if (gw + NGW < NTOK) issue_hr(gw + NGW, hrB); }
        else { issue_h(gw, v);
            if (COMB) { ti = tinfo[rowof(gw)]; issue_y(ti, ya, yc); if (gw + NGW < NTOK) tin = tinfo[rowof(gw + NGW)]; } } }
    auto body = [&](int tok) {
        const int b = tok / T, t = tok - b * T; const size_t row = (size_t)b * TP + t;
        if (COMB) {
#pragma unroll
            for (int jj = 0; jj < 4; ++jj) { const u32x4 a = ya[jj], c = yc[jj];
                v[2 * jj][0] += ti.w1 * bflo(a.x) + ti.w2 * bflo(c.x); v[2 * jj][1] += ti.w1 * bfhi(a.x) + ti.w2 * bfhi(c.x);
                v[2 * jj][2] += ti.w1 * bflo(a.y) + ti.w2 * bflo(c.y); v[2 * jj][3] += ti.w1 * bfhi(a.y) + ti.w2 * bfhi(c.y);
                v[2 * jj + 1][0] += ti.w1 * bflo(a.z) + ti.w2 * bflo(c.z); v[2 * jj + 1][1] += ti.w1 * bfhi(a.z) + ti.w2 * bfhi(c.z);
                v[2 * jj + 1][2] += ti.w1 * bflo(a.w) + ti.w2 * bflo(c.w); v[2 * jj + 1][3] += ti.w1 * bfhi(a.w) + ti.w2 * bfhi(c.w); }
        }
        if (MODE == 0 || MODE == 2) {
#pragma unroll
            for (int jj = 0; jj < 4; ++jj) { u32x4 w; w.x = pk2(v[2 * jj][0], v[2 * jj][1]); w.y = pk2(v[2 * jj][2], v[2 * jj][3]); w.z = pk2(v[2 * jj + 1][0], v[2 * jj + 1][1]); w.w = pk2(v[2 * jj + 1][2], v[2 * jj + 1][3]); ((u32x4*)(h + row * DM))[lane + 64 * jj] = w; }
        }
        float ss = 0.f;
#pragma unroll
        for (int j = 0; j < 8; ++j) ss += (v[j][0] * v[j][0] + v[j][1] * v[j][1]) + (v[j][2] * v[j][2] + v[j][3] * v[j][3]);
        const float rstd = rsqrtf(wave_sum(ss) * (1.0f / DM) + EPS);
#pragma unroll
        for (int j = 0; j < 8; ++j) v[j] = v[j] * rstd * g4[j];
        if (MODE == 3) {
            if (t >= NMETA && (!(ABL & 2) || v[0][0] == 1.2345e33f)) { float* o = p.out + ((size_t)b * SEQ + (t - NMETA)) * DM;
#pragma unroll
                for (int j = 0; j < 8; ++j) ((f32x4*)o)[128 * (j >> 1) + 2 * lane + (j & 1)] = v[j]; }
        } else {
#pragma unroll
            for (int jj = 0; jj < 4; ++jj) { hb[jj].x = pk2(v[2 * jj][0], v[2 * jj][1]); hb[jj].y = pk2(v[2 * jj][2], v[2 * jj][3]); hb[jj].z = pk2(v[2 * jj + 1][0], v[2 * jj + 1][1]); hb[jj].w = pk2(v[2 * jj + 1][2], v[2 * jj + 1][3]); ((u32x4*)(hn + row * DM))[lane + 64 * jj] = hb[jj]; }
        }
        auto dotc = [&](int c) -> float {
            const LAS u32x4* w = (const LAS u32x4*)(lds + c * 4096) + lane; float a = 0.f;
#pragma unroll
            for (int jj = 0; jj < 4; ++jj) { const u32x4 q = w[64 * jj];
                a = dot2bf(hb[jj].x, q.x, a); a = dot2bf(hb[jj].y, q.y, a); a = dot2bf(hb[jj].z, q.z, a); a = dot2bf(hb[jj].w, q.w, a); }
            return wave_sum(a);
        };
        if (MODE == 0) {
            float* logf_ = (float*)(ws + WS_LOGF);
#pragma unroll 1
            for (int c = 0; c < 8; ++c) { const float x = dotc(c) + ((const LAS float*)(lds + MISC_OFF + 1024))[c]; const float lf = fminf(x, 0.f) - log1pf(__expf(-fabsf(x)));
                if (lane == 0) logf_[(size_t)(b * 8 + c) * TP + t] = lf; }
        }
        if (MODE == 2) {
            float* gb = (float*)(ws + WS_GB); float* bb = (float*)(ws + WS_BB);
#pragma unroll 1
            for (int c = 0; c < 8; ++c) { const float a_in = dotc(c), b_in = dotc(8 + c);
                const LAS float* bl = (const LAS float*)(lds + MISC_OFF + 1024); const float g = -__expf(bl[c]) * softplusf_(a_in + bl[8 + c]), be = sigmoidf_(b_in);
                if (lane == 0) { gb[row * 8 + c] = g; bb[row * 8 + c] = be; } }
        }
        if (MODE == 1) {
            const LAS float* bg = (const LAS float*)(lds + MISC_OFF + 1024); const LAS float* be = bg + 4;
            int gs = 0; float gm = -3.0e38f, gsum = 0.f;
#pragma unroll 1
            for (int c = 0; c < 4; ++c) { const float l = dotc(c) + bg[c];
                if (l > gm) { gsum = gsum * __expf(gm - l) + 1.0f; gm = l; gs = c; } else gsum += __expf(l - gm); }
            const float gprob = 1.0f / gsum;
            gs = __builtin_amdgcn_readfirstlane(gs);
            int i1 = 0, i2 = 0; float m1 = -3.0e38f, m2 = -3.0e38f;
#pragma unroll 1
            for (int c = 0; c < 8; ++c) { const float l = dotc(4 + gs * 8 + c) + be[gs * 8 + c];
                if (l > m1) { m2 = m1; i2 = i1; m1 = l; i1 = c; } else if (l > m2) { m2 = l; i2 = c; } }
            const float e2 = __expf(m2 - m1), den = 1.0f / (1.0f + e2);
            if (lane == 0) {
                LAS unsigned* lcnt = (LAS unsigned*)(lds + MISC_OFF);
                TokInfo to; to.e1 = gs * 8 + i1; to.e2 = gs * 8 + i2; to.w1 = gprob * den; to.w2 = gprob * e2 * den;
                to.pos1 = (int)__hip_atomic_fetch_add(lcnt + to.e1, 1u, __ATOMIC_RELAXED, __HIP_MEMORY_SCOPE_WORKGROUP); to.pos2 = (int)__hip_atomic_fetch_add(lcnt + to.e2, 1u, __ATOMIC_RELAXED, __HIP_MEMORY_SCOPE_WORKGROUP); to.s1 = 0; to.s2 = 0;
                ((TokInfo*)(ws + WS_TOKINFO))[row] = to;
            }
        }
    };
    if (MODE == 1) {
        for (int tok = gw; tok < NTOK; tok += 2 * NGW) {
            cvt_hr(hrA); if (tok + 2 * NGW < NTOK) issue_hr(tok + 2 * NGW, hrA); body(tok);
            if (tok + NGW < NTOK) { cvt_hr(hrB); if (tok + 3 * NGW < NTOK) issue_hr(tok + 3 * NGW, hrB); body(tok + NGW); }
        }
    } else {
        for (int tok = gw; tok < NTOK; tok += NGW) {
            const int nt = tok + NGW;
            if (nt < NTOK) { issue_h(nt, vn); if (COMB) { issue_y(tin, yan, ycn); if (nt + NGW < NTOK) tin2 = tinfo[rowof(nt + NGW)]; } }
            body(tok);
            if (nt < NTOK) {
#pragma unroll
                for (int j = 0; j < 8; ++j) v[j] = vn[j];
                if (COMB) {
#pragma unroll
                    for (int jj = 0; jj < 4; ++jj) { ya[jj] = yan[jj]; yc[jj] = ycn[jj]; } }
                if (COMB) { ti = tin; tin = tin2; } }
        }
    }
    if (MODE == 1) {
        LAS unsigned* lcnt = (LAS unsigned*)(lds + MISC_OFF);
        __syncthreads();
        if (tid < NEXP) { const unsigned c = lcnt[tid]; ((unsigned*)(ws + WS_WGBASE))[blockIdx.x * NEXP + tid] = c ? atomicAdd((unsigned*)(ws + WS_CTL) + 64 * tid, c) : 0u; }
    }
}

__device__ __forceinline__ void moe_offsets(const unsigned* cnt, LAS int* tab  ) {
    if (threadIdx.x < NEXP) tab[32 + threadIdx.x] = (int)cnt[64 * threadIdx.x];
    __syncthreads();
    if (threadIdx.x == 0) { int acc = 0, nb = 0;
        for (int e = 0; e < NEXP; ++e) { const int c = tab[32 + e], pb = (c + 255) >> 8; tab[e] = acc; for (int q = 0; q < pb; ++q) tab[65 + nb + q] = e; nb += pb; acc += pb * 256; }
        tab[64] = nb; }
    __syncthreads();
}
__device__ __forceinline__ void moe_scatter_phase(const Params& p, LAS unsigned char* lds) {
    const int tid = threadIdx.x;
    unsigned char* ws = p.ws; LAS int* tab = (LAS int*)(lds + MISC_OFF);
    moe_offsets((const unsigned*)(ws + WS_CTL), tab);
    int* rowtok = (int*)(ws + WS_ROWTOK);
    const int gt = blockIdx.x * NTHR + tid, GT = gridDim.x * NTHR;
    for (int tok = gt; tok < NTOK; tok += GT) {
        const int b = tok / T, t = tok - b * T; const int row = b * TP + t;
        TokInfo* tip = (TokInfo*)(ws + WS_TOKINFO) + row; const TokInfo ti = *tip;
        const unsigned* wb = (const unsigned*)(ws + WS_WGBASE) + ((tok % (int)(gridDim.x * NWAVES)) / NWAVES) * NEXP;
        const int s1 = tab[ti.e1] + (int)wb[ti.e1] + ti.pos1, s2 = tab[ti.e2] + (int)wb[ti.e2] + ti.pos2;
        rowtok[s1] = row; rowtok[s2] = row; tip->s1 = s1; tip->s2 = s2;
    }
    for (int e = 0; e < NEXP; ++e) { const int c = tab[32 + e], r0 = tab[e] + c, r1 = tab[e] + ((c + 255) & ~255);
        for (int r = r0 + gt; r < r1; r += GT) rowtok[r] = T; }
}

__device__ __forceinline__ void fox_cumsum(const Params& p, LAS unsigned char* lds, int bh) {
    const int tid = threadIdx.x; const float* lf = (const float*)(p.ws + WS_LOGF) + (size_t)bh * TP; float* cb = (float*)(p.ws + WS_CB) + (size_t)bh * TP;
    LAS double* part = (LAS double*)lds;
    constexpr int PER = 17;
    double s = 0.0; const int i0 = tid * PER;
    for (int i = 0; i < PER; ++i) { const int t = i0 + i; if (t < T) s += (double)lf[t]; }
    part[tid] = s; __syncthreads();
    for (int o = 1; o < NTHR; o <<= 1) { const double a = tid >= o ? part[tid - o] : 0.0; __syncthreads(); part[tid] += a; __syncthreads(); }
    double run = tid ? part[tid - 1] : 0.0;
    for (int i = 0; i < PER; ++i) { const int t = i0 + i; if (t < T) { run += (double)lf[t]; cb[t] = (float)(-run * 11.313708498984761); } else if (t < TP) cb[t] = 0.f; }
    __syncthreads();
}

__device__ __forceinline__ void conv_phase(const Params& p, LAS unsigned char* lds) {
    const int tid = threadIdx.x, lane = tid & 63, wave = __builtin_amdgcn_readfirstlane(tid >> 6);
    const bf16* ug = (const bf16*)(p.ws + WS_U); bf16* a2 = (bf16*)(p.ws + WS_A2);
    const float* cw = p.in[7]; const float* cbias = p.in[8]; const float* lng = p.in[9]; const float* lnb = p.in[10];
    LAS unsigned char* ub = lds;
    LAS float* yb = (LAS float*)(lds + 38 * 2048);
    const int ch = 2 * tid;
    float w0[31], w1[31];
#pragma unroll
    for (int j = 0; j < 31; ++j) { const f32x2 w = *(const f32x2*)(cw + j * 1024 + ch); w0[j] = w.x; w1[j] = w.y; }
    const f32x2 cb2 = *(const f32x2*)(cbias + ch);
    constexpr int NT8 = T / 8, NITEM = 2 * NT8;
    u32x4 pre[10];
    auto issue = [&](int item) { const int b = item / NT8, t0 = (item - b * NT8) * 8;
#pragma unroll
        for (int k = 0; k < 10; ++k) { const int e = tid + NTHR * k, r = e >> 7, c = e & 127, t = t0 - 30 + r; pre[k] = (u32x4){0u, 0u, 0u, 0u};
            if (r < 38 && t >= 0) pre[k] = *(const u32x4*)(ug + ((size_t)b * TP + t) * 1024 + c * 8); } };
    int item = blockIdx.x;
    if (item < NITEM) issue(item);
    for (; item < NITEM; item += gridDim.x) {
        const int b = item / NT8, t0 = (item - b * NT8) * 8;
#pragma unroll
        for (int k = 0; k < 10; ++k) { const int e = tid + NTHR * k; if (e < 38 * 128) *(LAS u32x4*)(ub + e * 16) = pre[k]; }
        LBAR();
        if (item + (int)gridDim.x < NITEM) issue(item + gridDim.x);
        float a0[8], a1[8];
#pragma unroll
        for (int q = 0; q < 8; ++q) { a0[q] = cb2.x; a1[q] = cb2.y; }
#pragma unroll
        for (int r = 0; r < 38; ++r) { const unsigned uu = *(const LAS unsigned*)(ub + r * 2048 + ch * 2); const float u0 = bflo(uu), u1 = bfhi(uu);
#pragma unroll
            for (int q = 0; q < 8; ++q) { const int j = r - q; if (j >= 0 && j < 31) { a0[q] += w0[j] * u0; a1[q] += w1[j] * u1; } } }
#pragma unroll
        for (int q = 0; q < 8; ++q) *(LAS f32x2*)(yb + q * 1024 + ch) = (f32x2){a0[q], a1[q]};
        LBAR();
        { const int q = wave, t = t0 + q;
          f32x4 v[4]; float s = 0.f;
#pragma unroll
          for (int j = 0; j < 4; ++j) { v[j] = *(const LAS f32x4*)(yb + q * 1024 + 512 * (j >> 1) + 8 * lane + 4 * (j & 1)); s += (v[j][0] + v[j][1]) + (v[j][2] + v[j][3]); }
          const float mu = wave_sum(s) * (1.0f / 1024.0f); float s2 = 0.f;
#pragma unroll
          for (int j = 0; j < 4; ++j) { v[j] = v[j] - mu; s2 += (v[j][0] * v[j][0] + v[j][1] * v[j][1]) + (v[j][2] * v[j][2] + v[j][3] * v[j][3]); }
          const float rstd = rsqrtf(wave_sum(s2) * (1.0f / 1024.0f) + EPS);
          bf16* orow = a2 + ((size_t)b * TP + t) * DM + 1024;
#pragma unroll
          for (int jj = 0; jj < 2; ++jj) { const int c0 = 512 * jj + 8 * lane;
              const f32x4 g0 = *(const f32x4*)(lng + c0), g1 = *(const f32x4*)(lng + c0 + 4), b0 = *(const f32x4*)(lnb + c0), b1 = *(const f32x4*)(lnb + c0 + 4);
              const f32x4 y0 = v[2 * jj] * rstd * g0 + b0, y1 = v[2 * jj + 1] * rstd * g1 + b1;
              u32x4 w; w.x = pk2(siluf_(y0[0]), siluf_(y0[1])); w.y = pk2(siluf_(y0[2]), siluf_(y0[3])); w.z = pk2(siluf_(y1[0]), siluf_(y1[1])); w.w = pk2(siluf_(y1[2]), siluf_(y1[3]));
              *(u32x4*)(orow + c0) = w; } }
        LBAR();
    }
}

typedef att::BlockRef<att::bf16, att::bf16> ABlock;
__device__ __forceinline__ ABlock att_block(const Params& p, int bh, int qb) {
    const int b = bh >> 3, hh = bh & 7; const bf16* z = (const bf16*)(p.ws + WS_Z); const size_t row0 = (size_t)b * TP;
    ABlock r; r.Q = z + (row0 + (size_t)qb * 256) * LDZ0 + hh * 128; r.K = z + row0 * LDZ0 + 1024 + hh * 128; r.V = z + row0 * LDZ0 + 2048 + hh * 128;
    r.O = (bf16*)(p.ws + WS_A2) + (row0 + (size_t)qb * 256) * DM + hh * 128; r.C = (const float*)(p.ws + WS_CB) + (size_t)bh * TP; r.P0 = qb * 256; return r;
}
__device__ __forceinline__ bool att_stream(int G, int c, int idx, int& bh, int& qb) {
    int L = c;
    for (;;) { if (L >= 272) return false; const int nb = L < 256 ? 2 : 1; if (idx < nb) break; idx -= nb; L += G; }
    if (L < 256) { bh = L >> 4; const int x = L & 15; qb = idx ? 32 - x : 1 + x; } else { bh = L - 256; qb = 0; }
    return true;
}
__device__ __forceinline__ void mix0_phase(const Params& p, LAS unsigned char* lds) {
    const int G = gridDim.x, c = blockIdx.x;
    int bh, qb;
    if (att_stream(G, c, 0, bh, qb)) {
        att::Seam<att::bf16> S;
        ABlock cur = att_block(p, bh, qb);
        att::causal_swa_prime<att::bf16, att::bf16>(cur, 1 << 30, (char*)lds, S);
        for (int idx = 0;; ++idx) {
            int bh2, qb2; const bool more = att_stream(G, c, idx + 1, bh2, qb2);
            const ABlock nxt = more ? att_block(p, bh2, qb2) : cur;
            att::causal_swa_block<att::bf16, att::bf16>(cur, nxt, TP, 1 << 30, (char*)lds, S);
            if (!more) break;
            cur = nxt;
        }
        asm volatile("s_waitcnt vmcnt(0)" ::: "memory"); __syncthreads();
    }
}
constexpr int PREP_SPLIT = 96;
#define PREP_ITEM(w) (((w) & 15) * NCHUNK + ((w) >> 4))
constexpr size_t WS_FLAG = WS_BAR + 16 * 1024;

typedef short pbf16x8 __attribute__((ext_vector_type(8)));
__device__ __forceinline__ void rot8(float (&x)[8], int k) {
    float t[8];
#pragma unroll
    for (int e = 0; e < 8; ++e) t[e] = (k & 1) ? x[(e + 1) & 7] : x[e];
#pragma unroll
    for (int e = 0; e < 8; ++e) x[e] = (k & 2) ? t[(e + 2) & 7] : t[e];
#pragma unroll
    for (int e = 0; e < 8; ++e) t[e] = (k & 4) ? x[(e + 4) & 7] : x[e];
#pragma unroll
    for (int e = 0; e < 8; ++e) x[e] = t[e];
}
struct PrepPre { u32x4 z[16]; float g, be; };
__device__ __forceinline__ void gdn_prep_issue(const Params& p, int item, PrepPre& P) {
    const int tid = threadIdx.x, lane = tid & 63;
    const int bh = item / NCHUNK, n = item - bh * NCHUNK, b = bh >> 3, hh = bh & 7;
    const bf16* z = (const bf16*)(p.ws + WS_Z);
#pragma unroll
    for (int pp = 0; pp < 4; ++pp) { const int part = pp >> 1, i = (pp & 1) * 32 + (tid >> 4), d0 = (tid & 15) * 8, t = 64 * n - 48 + i, col = part * 1024 + hh * 128 + d0;
#pragma unroll
        for (int j = 0; j < 4; ++j) { const int ts = t - 3 + j; P.z[pp * 4 + j] = (u32x4){0u, 0u, 0u, 0u};
            if (ts >= 0) P.z[pp * 4 + j] = *(const u32x4*)(z + ((size_t)b * TP + ts) * LDZ1 + col); } }
    P.g = 0.f; P.be = 0.f;
    if (tid < 64) { const int t = 64 * n - 48 + lane; if (t >= 0) { const size_t row = (size_t)b * TP + t; P.g = ((const float*)(p.ws + WS_GB))[row * 8 + hh]; P.be = ((const float*)(p.ws + WS_BB))[row * 8 + hh]; } }
}
template <int ABL = 0> __device__ __forceinline__ void gdn_prep_item(const Params& p, LAS unsigned char* lds, int item, PrepPre& P, int next) {
    const int tid = threadIdx.x, lane = tid & 63, wave = __builtin_amdgcn_readfirstlane(tid >> 6);
    const int bh = item / NCHUNK, n = item - bh * NCHUNK, b = bh >> 3, hh = bh & 7;
    unsigned char* ws = p.ws; const bf16* z = (const bf16*)(ws + WS_Z);
    constexpr int LK = 136, LT = 72;
    LAS bf16* Kb = (LAS bf16*)lds; LAS bf16* Qb = Kb + 64 * LK; LAS bf16* VbT = Qb + 64 * LK; LAS bf16* KgT = VbT + 128 * LT; LAS bf16* KdT = KgT + 128 * LT;
    LAS float* As = (LAS float*)(KdT + 128 * LT); LAS float* Ts = As + 64 * 65; LAS float* Ms = Ts + 64 * 65; LAS bf16* Tb = (LAS bf16*)(Ms + 32 * 34);
    LAS bf16* Vb = (LAS bf16*)As;
    LAS float* gcs = (LAS float*)(Tb + 64 * LT); LAS float* bes = gcs + 64; LAS float* egs = bes + 64; LAS float* ekd = egs + 64;
    const float* cw = p.in[13];
    LAS float* cwl = ekd + 64;
    for (int e = tid; e < 3 * 4 * 128; e += NTHR) { const int pj = e >> 7, d = e & 127; cwl[e] = cw[(pj & 3) * 3072 + (pj >> 2) * 1024 + hh * 128 + d]; }
    if (wave == 0) { const float g = P.g, be = P.be;
        float c = g;
#pragma unroll
        for (int o = 1; o < 64; o <<= 1) { const float u = __shfl_up(c, o); if (lane >= o) c += u; }
        const float gl = __shfl(c, 63);
        gcs[lane] = c; bes[lane] = be; egs[lane] = __expf(c); ekd[lane] = __expf(gl - c);
        if (lane == 0) ((float*)(ws + WS_GT))[item] = __expf(gl); }
    __syncthreads();
    bf16* qdg = (bf16*)(ws + WS_GQD) + (size_t)item * 8192;
#pragma unroll
    for (int pp = 0; pp < ((ABL & 2) ? 0 : (ABL & 16) ? 4 : 6); ++pp) {
        const int part = pp >> 1, i = (pp & 1) * 32 + (tid >> 4), d0 = (tid & 15) * 8, t = 64 * n - 48 + i, col = part * 1024 + hh * 128 + d0;
        float x[8];
#pragma unroll
        for (int e = 0; e < 8; ++e) x[e] = 0.f;
        if (t >= 0) {
#pragma unroll
            for (int j = 0; j < 4; ++j) { const int ts = t - 3 + j;
                if (ts >= 0) { const u32x4 zz = (pp < 4 || (ABL & 8)) ? P.z[(pp & 3) * 4 + j] : *(const u32x4*)(z + ((size_t)b * TP + ts) * LDZ1 + col); const f32x4 wa = *(const LAS f32x4*)(cwl + (part * 4 + j) * 128 + d0), wb = *(const LAS f32x4*)(cwl + (part * 4 + j) * 128 + d0 + 4);
                    x[0] += wa[0] * bflo(zz.x); x[1] += wa[1] * bfhi(zz.x); x[2] += wa[2] * bflo(zz.y); x[3] += wa[3] * bfhi(zz.y);
                    x[4] += wb[0] * bflo(zz.z); x[5] += wb[1] * bfhi(zz.z); x[6] += wb[2] * bflo(zz.w); x[7] += wb[3] * bfhi(zz.w); } }
            if (!(ABL & 32)) {
#pragma unroll
            for (int e = 0; e < 8; ++e) x[e] = siluf_(x[e]); }
        }
        float ss = 0.f;
#pragma unroll
        for (int e = 0; e < 8; ++e) ss += x[e] * x[e];
        ss = row16_sum(ss);
        const float rn = rsqrtf(ss + EPS), be = bes[i], eg = egs[i];
        if (part == 0) { const float sc = rn * 0.08838834764831845f; u32x4 w, wd;
            w.x = pk2(x[0] * sc, x[1] * sc); w.y = pk2(x[2] * sc, x[3] * sc); w.z = pk2(x[4] * sc, x[5] * sc); w.w = pk2(x[6] * sc, x[7] * sc);
            *(LAS u32x4*)(Qb + i * LK + d0) = w;
            const float sd = sc * eg; wd.x = pk2(x[0] * sd, x[1] * sd); wd.y = pk2(x[2] * sd, x[3] * sd); wd.z = pk2(x[4] * sd, x[5] * sd); wd.w = pk2(x[6] * sd, x[7] * sd);
            *(u32x4*)(qdg + i * 128 + d0) = wd;
        } else if (part == 1) { u32x4 w; w.x = pk2(x[0] * rn, x[1] * rn); w.y = pk2(x[2] * rn, x[3] * rn); w.z = pk2(x[4] * rn, x[5] * rn); w.w = pk2(x[6] * rn, x[7] * rn);
            *(LAS u32x4*)(Kb + i * LK + d0) = w;
        } else { u32x4 w; w.x = pk2(x[0] * be, x[1] * be); w.y = pk2(x[2] * be, x[3] * be); w.z = pk2(x[4] * be, x[5] * be); w.w = pk2(x[6] * be, x[7] * be);
            *(LAS u32x4*)(Vb + i * LK + d0) = w;
        }
    }
    if (next < NCH) gdn_prep_issue(p, next, P);
    LBAR();
    { const int d = tid & 127, i0 = (tid >> 7) * 16; unsigned pv[8], pg[8], pd[8];
#pragma unroll
      for (int k = 0; k < 8; ++k) { const int i = i0 + 2 * k;
          const float k0 = bf2f(Kb[i * LK + d]), k1 = bf2f(Kb[(i + 1) * LK + d]);
          pv[k] = (unsigned)Vb[i * LK + d] | ((unsigned)Vb[(i + 1) * LK + d] << 16);
          pg[k] = pk2(k0 * (bes[i] * egs[i]), k1 * (bes[i + 1] * egs[i + 1])); pd[k] = pk2(k0 * ekd[i], k1 * ekd[i + 1]); }
      *(LAS u32x4*)(VbT + d * LT + i0) = (u32x4){pv[0], pv[1], pv[2], pv[3]}; *(LAS u32x4*)(VbT + d * LT + i0 + 8) = (u32x4){pv[4], pv[5], pv[6], pv[7]};
      *(LAS u32x4*)(KgT + d * LT + i0) = (u32x4){pg[0], pg[1], pg[2], pg[3]}; *(LAS u32x4*)(KgT + d * LT + i0 + 8) = (u32x4){pg[4], pg[5], pg[6], pg[7]};
      *(LAS u32x4*)(KdT + d * LT + i0) = (u32x4){pd[0], pd[1], pd[2], pd[3]}; *(LAS u32x4*)(KdT + d * LT + i0 + 8) = (u32x4){pd[4], pd[5], pd[6], pd[7]}; }
    LBAR();
    { const int r = lane & 15, q = lane >> 4, ib = wave >> 1; bf16* attg = (bf16*)(ws + WS_GATT) + (size_t)item * 4096;
#pragma unroll
      for (int jj = 0; jj < 2; ++jj) { const int jb = (wave & 1) * 2 + jj;
          f32x4 g1 = (f32x4){0.f, 0.f, 0.f, 0.f}, g2 = g1;
          if (jb <= ib) {
#pragma unroll
              for (int s = 0; s < 4; ++s) { const pbf16x8 ak = *(const LAS pbf16x8*)(Kb + (ib * 16 + r) * LK + 32 * s + 8 * q), aq = *(const LAS pbf16x8*)(Qb + (ib * 16 + r) * LK + 32 * s + 8 * q), bk = *(const LAS pbf16x8*)(Kb + (jb * 16 + r) * LK + 32 * s + 8 * q);
                  g1 = __builtin_amdgcn_mfma_f32_16x16x32_bf16(ak, bk, g1, 0, 0, 0); g2 = __builtin_amdgcn_mfma_f32_16x16x32_bf16(aq, bk, g2, 0, 0, 0); } }
          const int j = jb * 16 + r; const float gj = gcs[j];
#pragma unroll
          for (int e = 0; e < 4; ++e) { const int i = ib * 16 + 4 * q + e; const float dec = __expf(gcs[i] - gj);
              As[i * 65 + j] = j < i ? g1[e] * dec * bes[i] : 0.f; attg[i * 64 + j] = (bf16)f2bf(j <= i ? g2[e] * dec : 0.f); } } }
    LBAR();
    if (!(ABL & 1)) {
    for (int e = tid; e < 64 * 65; e += NTHR) Ts[e] = 0.f;
    LBAR();
    if (tid < 64) { const int I = tid >> 4, c = tid & 15; float x[16];
#pragma unroll
        for (int i = 0; i < 16; ++i) { float a = (i == c) ? 1.0f : 0.0f;
#pragma unroll
            for (int j = 0; j < i; ++j) a -= As[(I * 16 + i) * 65 + I * 16 + j] * x[j];
            x[i] = a; }
#pragma unroll
        for (int i = 0; i < 16; ++i) Ts[(I * 16 + i) * 65 + I * 16 + c] = x[i]; }
    LBAR();
    { const int I = (tid >> 8) * 2 + 1, a = (tid >> 4) & 15, bq = tid & 15; float m = 0.f;
#pragma unroll
      for (int c = 0; c < 16; ++c) m += As[(I * 16 + a) * 65 + (I - 1) * 16 + c] * Ts[((I - 1) * 16 + c) * 65 + (I - 1) * 16 + bq];
      Ms[(tid >> 4) * 34 + bq] = m;
      LBAR();
      float t = 0.f;
#pragma unroll
      for (int c = 0; c < 16; ++c) t -= Ts[(I * 16 + a) * 65 + I * 16 + c] * Ms[((tid >> 8) * 16 + c) * 34 + bq];
      LBAR();
      Ts[(I * 16 + a) * 65 + (I - 1) * 16 + bq] = t; }
    LBAR();
    { float m[2];
#pragma unroll
      for (int h = 0; h < 2; ++h) { const int e = tid + NTHR * h, a = e >> 5, bq = e & 31; float v = 0.f;
#pragma unroll
          for (int c = 0; c < 32; ++c) v += As[(32 + a) * 65 + c] * Ts[c * 65 + bq];
          m[h] = v; }
#pragma unroll
      for (int h = 0; h < 2; ++h) { const int e = tid + NTHR * h; Ms[(e >> 5) * 34 + (e & 31)] = m[h]; }
      LBAR();
#pragma unroll
      for (int h = 0; h < 2; ++h) { const int e = tid + NTHR * h, a = e >> 5, bq = e & 31; float v = 0.f;
#pragma unroll
          for (int c = 0; c < 32; ++c) v -= Ts[(32 + a) * 65 + 32 + c] * Ms[c * 34 + bq];
          m[h] = v; }
      LBAR();
#pragma unroll
      for (int h = 0; h < 2; ++h) { const int e = tid + NTHR * h; Ts[(32 + (e >> 5)) * 65 + (e & 31)] = m[h]; } }
    LBAR();
    }
    for (int e = tid; e < 4096; e += NTHR) { const int i = e >> 6, j = e & 63; Tb[i * LT + j] = (bf16)f2bf(((j >> 4) < (i >> 4) || ((j >> 4) == (i >> 4) && j <= i)) ? Ts[i * 65 + j] : 0.f); }
    LBAR();
    if (!(ABL & 4)) { const int r = lane & 15, q = lane >> 4, db = wave; bf16* ug = (bf16*)(ws + WS_GU) + (size_t)item * 8192; bf16* wg = (bf16*)(ws + WS_GW) + (size_t)item * 8192;
      pbf16x8 bv[2], bk[2];
#pragma unroll
      for (int s = 0; s < 2; ++s) { bv[s] = *(const LAS pbf16x8*)(VbT + (db * 16 + r) * LT + 32 * s + 8 * q); bk[s] = *(const LAS pbf16x8*)(KgT + (db * 16 + r) * LT + 32 * s + 8 * q); }
#pragma unroll
      for (int ib = 0; ib < 4; ++ib) { f32x4 au = (f32x4){0.f, 0.f, 0.f, 0.f}, aw = au;
#pragma unroll
          for (int s = 0; s < 2; ++s) { const pbf16x8 at = *(const LAS pbf16x8*)(Tb + (ib * 16 + r) * LT + 32 * s + 8 * q);
              au = __builtin_amdgcn_mfma_f32_16x16x32_bf16(at, bv[s], au, 0, 0, 0); aw = __builtin_amdgcn_mfma_f32_16x16x32_bf16(at, bk[s], aw, 0, 0, 0); }
          u32x2 pu; pu.x = pk2(au[0], au[1]); pu.y = pk2(au[2], au[3]); *(u32x2*)(ug + (db * 16 + r) * 64 + ib * 16 + 4 * q) = pu;
#pragma unroll
          for (int e = 0; e < 4; ++e) Kb[(ib * 16 + 4 * q + e) * LK + db * 16 + r] = (bf16)f2bf(-aw[e]); }
      LBAR();
      for (int e = tid; e < 1024; e += NTHR) { const int row = e >> 4, c = e & 15; *(u32x4*)(wg + row * 128 + c * 8) = *(const LAS u32x4*)(Kb + row * LK + c * 8); } }
    if (!(ABL & 4)) { bf16* kdg = (bf16*)(ws + WS_GKD) + (size_t)item * 8192;
      for (int e = tid; e < 1024; e += NTHR) { const int row = e >> 3, c = e & 7; *(u32x4*)(kdg + row * 64 + c * 8) = *(const LAS u32x4*)(KdT + row * LT + c * 8); } }
    LBAR();
}

typedef short gbf16x8 __attribute__((ext_vector_type(8)));
struct GdnSet { u32x4 w[2], qd[2], kd[2], at, u; float gt; };
constexpr int GS_W = 0, GS_QD = 17408, GS_KD = 34816, GS_AT = 53248, GS_U = 62464, GS_SLOT = 67072;
__device__ __forceinline__ void gdn_issue(GdnSet& o, const unsigned char* ws, size_t ci, int sl, int tid) {
    const u32x4* wg = (const u32x4*)((const bf16*)(ws + WS_GW) + ci * 8192); const u32x4* qg = (const u32x4*)((const bf16*)(ws + WS_GQD) + ci * 8192); const u32x4* kg = (const u32x4*)((const bf16*)(ws + WS_GKD) + ci * 8192);
#pragma unroll
    for (int k = 0; k < 2; ++k) { o.w[k] = wg[tid + 512 * k]; o.qd[k] = qg[tid + 512 * k]; o.kd[k] = kg[tid + 512 * k]; }
    o.at = ((const u32x4*)((const bf16*)(ws + WS_GATT) + ci * 4096))[tid];
    o.u = ((const u32x4*)((const bf16*)(ws + WS_GU) + ci * 8192 + sl * 32 * 64))[tid & 255];
    o.gt = ((const float*)(ws + WS_GT))[ci];
}
__device__ __forceinline__ void gdn_put(const GdnSet& o, LAS unsigned char* slot, int tid) {
#pragma unroll
    for (int k = 0; k < 2; ++k) { const int c = tid + 512 * k;
        *(LAS u32x4*)(slot + GS_W + (c >> 4) * 272 + (c & 15) * 16) = o.w[k]; *(LAS u32x4*)(slot + GS_QD + (c >> 4) * 272 + (c & 15) * 16) = o.qd[k];
        *(LAS u32x4*)(slot + GS_KD + (c >> 3) * 144 + (c & 7) * 16) = o.kd[k]; }
    *(LAS u32x4*)(slot + GS_AT + (tid >> 3) * 144 + (tid & 7) * 16) = o.at;
    if (tid < 256) *(LAS u32x4*)(slot + GS_U + (tid >> 3) * 144 + (tid & 7) * 16) = o.u;
}
template <int ABL = 0, bool LATE = false> __device__ __forceinline__ void gdn_scan_item(const Params& p, LAS unsigned char* lds, int item) {
    const int tid = threadIdx.x, lane = tid & 63, wave = __builtin_amdgcn_readfirstlane(tid >> 6);
    const int bh = item >> 2, sl = item & 3, b = bh >> 3, hh = bh & 7;
    const int ib = wave >> 1, vb = wave & 1, kb = wave, r = lane & 15, q = lane >> 4;
    unsigned char* ws = p.ws;
    constexpr int LDS_K = 136, LDS_I = 72;
    LAS bf16* ST = (LAS bf16*)(lds + 2 * GS_SLOT); LAS bf16* VNT = ST + 32 * LDS_K;
    for (int e = tid; e < 32 * LDS_K / 2; e += NTHR) ((LAS unsigned*)ST)[e] = 0u;
    f32x4 S0 = (f32x4){0.f, 0.f, 0.f, 0.f}, S1 = S0;
    float* og = (float*)(ws + WS_O) + hh * 128 + sl * 32 + vb * 16 + r; float* dump = (float*)(ws + WS_DUMP) + tid;
    const size_t ci0 = (size_t)bh * NCHUNK;
    GdnSet R0, R1, R2;
    gdn_issue(R0, ws, ci0 + 0, sl, tid); gdn_issue(R1, ws, ci0 + 1, sl, tid); gdn_issue(R2, ws, ci0 + 2, sl, tid);
    gdn_put(R0, lds, tid); float gt_cur = R0.gt;
    __syncthreads();
    auto step = [&](int n, GdnSet& fr, GdnSet& nx) {
        if (!(ABL & 1)) gdn_issue(fr, ws, ci0 + (n + 3 < NCHUNK ? n + 3 : NCHUNK - 1), sl, tid);
        const LAS unsigned char* slot = lds + (n & 1) * GS_SLOT;
        if (!(ABL & 2)) gdn_put(nx, lds + ((n + 1) & 1) * GS_SLOT, tid);
        const float gt_next = nx.gt;
        const u32x2 uu = *(const LAS u32x2*)(slot + GS_U + (vb * 16 + r) * 144 + (ib * 16 + 4 * q) * 2);
        f32x4 vn = (f32x4){bflo(uu.x), bfhi(uu.x), bflo(uu.y), bfhi(uu.y)}, oo = (f32x4){0.f, 0.f, 0.f, 0.f};
        const LAS bf16* sp = ST + (vb * 16 + r) * LDS_K + 8 * q;
        const LAS unsigned char* wp = slot + GS_W + (ib * 16 + r) * 272 + 16 * q; const LAS unsigned char* qp = slot + GS_QD + (ib * 16 + r) * 272 + 16 * q;
#pragma unroll
        for (int s = 0; s < 4; ++s) { const gbf16x8 bs = *(const LAS gbf16x8*)(sp + 32 * s);
            vn = __builtin_amdgcn_mfma_f32_16x16x32_bf16(*(const LAS gbf16x8*)(wp + 64 * s), bs, vn, 0, 0, 0); oo = __builtin_amdgcn_mfma_f32_16x16x32_bf16(*(const LAS gbf16x8*)(qp + 64 * s), bs, oo, 0, 0, 0); }
        { u32x2 pk; pk.x = pk2(vn[0], vn[1]); pk.y = pk2(vn[2], vn[3]); *(LAS u32x2*)(VNT + (vb * 16 + r) * LDS_I + ib * 16 + 4 * q) = pk; }
        LBAR();
        S0 = S0 * gt_cur; S1 = S1 * gt_cur;
        const LAS unsigned char* ap = slot + GS_AT + (ib * 16 + r) * 144 + 16 * q; const LAS unsigned char* kp = slot + GS_KD + (kb * 16 + r) * 144 + 16 * q;
#pragma unroll
        for (int s = 0; s < 2; ++s) { const gbf16x8 b0 = *(const LAS gbf16x8*)(VNT + r * LDS_I + 32 * s + 8 * q), b1 = *(const LAS gbf16x8*)(VNT + (16 + r) * LDS_I + 32 * s + 8 * q);
            const gbf16x8 ka = *(const LAS gbf16x8*)(kp + 64 * s);
            oo = __builtin_amdgcn_mfma_f32_16x16x32_bf16(*(const LAS gbf16x8*)(ap + 64 * s), vb ? b1 : b0, oo, 0, 0, 0);
            S0 = __builtin_amdgcn_mfma_f32_16x16x32_bf16(ka, b0, S0, 0, 0, 0); S1 = __builtin_amdgcn_mfma_f32_16x16x32_bf16(ka, b1, S1, 0, 0, 0); }
        { u32x2 pk; pk.x = pk2(S0[0], S0[1]); pk.y = pk2(S0[2], S0[3]); *(LAS u32x2*)(ST + r * LDS_K + kb * 16 + 4 * q) = pk;
          pk.x = pk2(S1[0], S1[1]); pk.y = pk2(S1[2], S1[3]); *(LAS u32x2*)(ST + (16 + r) * LDS_K + kb * 16 + 4 * q) = pk; }
#pragma unroll
        for (int e = 0; e < 4; ++e) { const int t = 64 * n - 48 + ib * 16 + 4 * q + e; float* dst = t >= 0 ? og + ((size_t)b * TP + t) * 1024 : dump; if (!(ABL & 4)) *dst = oo[e]; else if (oo[e] == 1.2345e33f) *dst = 0.f; }
        gt_cur = gt_next;
        LBAR();
    };
    static_assert(NCHUNK % 3 == 0, "129 chunks = 43 x 3");
    constexpr int NW1 = PREP_SPLIT - 3;
    static_assert(NW1 % 3 == 0 && NW1 > 0, "the wait sits between two unrolled trips");
    for (int n = 0; n < (LATE ? NW1 : NCHUNK); n += 3) { step(n, R0, R1); step(n + 1, R1, R2); step(n + 2, R2, R0); }
    if (LATE) {
        if (tid == 0) { unsigned sp = 0; const unsigned want = gridDim.x - 64;
            while (__hip_atomic_load((unsigned*)(ws + WS_FLAG), __ATOMIC_RELAXED, __HIP_MEMORY_SCOPE_AGENT) < want) { __builtin_amdgcn_s_sleep(2); if (++sp > (1u << 22)) break; } }
        __syncthreads();
        __builtin_amdgcn_fence(__ATOMIC_ACQUIRE, "agent"); asm volatile("s_waitcnt vmcnt(0)" ::: "memory");
        for (int n = NW1; n < NCHUNK; n += 3) { step(n, R0, R1); step(n + 1, R1, R2); step(n + 2, R2, R0); }
    }
}

typedef short lbf16x8 __attribute__((ext_vector_type(8)));
__device__ __forceinline__ void lru_item(const Params& p, LAS unsigned char* lds, int item) {
    const int tid = threadIdx.x, lane = tid & 63, wave = __builtin_amdgcn_readfirstlane(tid >> 6);
    const int blk = item & 7, bn = item >> 3, b = bn / NCHUNK, n = bn - b * NCHUNK;
    unsigned char* ws = p.ws; const bf16* z = (const bf16*)(ws + WS_Z);
    constexpr int LD = 129, LB = 136;
    LAS float* Xf = (LAS float*)lds; LAS bf16* Xb = (LAS bf16*)(lds + 33024); LAS float* Af = (LAS float*)(lds + 50432); LAS float* Bf = (LAS float*)(lds + 83456);
    LAS float* Pq = (LAS float*)(lds + 116480); LAS float* Hq = Pq + 512;
    LAS bf16* HLb = (LAS bf16*)lds; LAS bf16* PPb = HLb + 64 * 128;
    const int r = lane & 15, q = lane >> 4, ob = wave;
    lbf16x8 br[4], bi[4];
    { const bf16* wr = (const bf16*)(ws + WS_LRUW) + (size_t)blk * 16384 + (ob * 16 + r) * 128 + 8 * q; const bf16* wi = wr + 8 * 16384;
#pragma unroll
      for (int s = 0; s < 4; ++s) { br[s] = *(const lbf16x8*)(wr + 32 * s); bi[s] = *(const lbf16x8*)(wi + 32 * s); } }
    { const int cg = tid & 15, ch0 = blk * 128 + cg * 8; const float* cw = p.in[17]; const float* cb = p.in[18];
      f32x4 wa[4], wb[4];
#pragma unroll
      for (int j = 0; j < 4; ++j) { wa[j] = *(const f32x4*)(cw + j * 1024 + ch0); wb[j] = *(const f32x4*)(cw + j * 1024 + ch0 + 4); }
      const f32x4 ba = *(const f32x4*)(cb + ch0), bb = *(const f32x4*)(cb + ch0 + 4);
#pragma unroll
      for (int h = 0; h < 2; ++h) { const int i = (tid >> 4) + 32 * h, t = 64 * n - 48 + i; float x[8];
#pragma unroll
          for (int e = 0; e < 8; ++e) x[e] = 0.f;
          if (t >= 0) {
#pragma unroll
              for (int e = 0; e < 4; ++e) { x[e] = ba[e]; x[4 + e] = bb[e]; }
#pragma unroll
              for (int j = 0; j < 4; ++j) { const int ts = t - 3 + j;
                  if (ts >= 0) { const u32x4 zz = *(const u32x4*)(z + ((size_t)b * TP + ts) * LDZ1 + 4096 + ch0);
                      x[0] += wa[j][0] * bflo(zz.x); x[1] += wa[j][1] * bfhi(zz.x); x[2] += wa[j][2] * bflo(zz.y); x[3] += wa[j][3] * bfhi(zz.y);
                      x[4] += wb[j][0] * bflo(zz.z); x[5] += wb[j][1] * bfhi(zz.z); x[6] += wb[j][2] * bflo(zz.w); x[7] += wb[j][3] * bfhi(zz.w); } } }
#pragma unroll
          for (int e = 0; e < 8; ++e) Xf[i * LD + cg * 8 + e] = x[e];
          u32x4 w; w.x = pk2(x[0], x[1]); w.y = pk2(x[2], x[3]); w.z = pk2(x[4], x[5]); w.w = pk2(x[6], x[7]); *(LAS u32x4*)(Xb + i * LB + cg * 8) = w; } }
    __syncthreads();
    { const int ch = blk * 128 + ob * 16 + r; const float brg = p.in[20][ch], big = p.in[22][ch], spl = softplusf_(-p.in[23][ch]);
#pragma unroll
      for (int ib = 0; ib < 4; ++ib) { f32x4 ar = (f32x4){0.f, 0.f, 0.f, 0.f}, ai = ar;
#pragma unroll
          for (int s = 0; s < 4; ++s) { const lbf16x8 ax = *(const LAS lbf16x8*)(Xb + (ib * 16 + r) * LB + 32 * s + 8 * q);
              ar = __builtin_amdgcn_mfma_f32_16x16x32_bf16(ax, br[s], ar, 0, 0, 0); ai = __builtin_amdgcn_mfma_f32_16x16x32_bf16(ax, bi[s], ai, 0, 0, 0); }
#pragma unroll
          for (int e = 0; e < 4; ++e) { const int i = ib * 16 + 4 * q + e, t = 64 * n - 48 + i, o = ob * 16 + r;
              const float rg = sigmoidf_(ar[e] + brg), ig = sigmoidf_(ai[e] + big), x = Xf[i * LD + o];
              const float log_a = -8.0f * spl * rg; const float a = __expf(log_a), bq = __builtin_amdgcn_sqrtf(fmaxf(1.0f - a * a, 0.f)) * (ig * x);
              Af[i * LD + o] = t >= 0 ? a : 1.0f; Bf[i * LD + o] = t >= 0 ? bq : 0.f; } } }
    __syncthreads();
    { const int c = tid & 127, qq = tid >> 7; float hl = 0.f, pp = 1.0f;
#pragma unroll
      for (int k = 0; k < 16; ++k) { const int i = qq * 16 + k; const float a = Af[i * LD + c]; hl = a * hl + Bf[i * LD + c]; pp *= a; Af[i * LD + c] = pp; Bf[i * LD + c] = hl; }
      Pq[qq * 128 + c] = pp; Hq[qq * 128 + c] = hl;
      __syncthreads();
      float cin = 0.f, pin = 1.0f;
#pragma unroll
      for (int k = 0; k < 3; ++k) if (k < qq) { const float pk = Pq[k * 128 + c]; cin = pk * cin + Hq[k * 128 + c]; pin *= pk; }
#pragma unroll
      for (int k = 0; k < 16; ++k) { const int i = qq * 16 + k; const float pl = Af[i * LD + c]; const float hf = Bf[i * LD + c] + pl * cin, pf = pl * pin;
          HLb[i * 128 + c] = (bf16)f2bf(hf); PPb[i * 128 + c] = (bf16)f2bf(pf);
          if (i == 63) { const int ch = blk * 128 + c; ((float*)(ws + WS_LRUA))[((size_t)b * NCHUNK + n) * 1024 + ch] = pf; ((float*)(ws + WS_LRUB))[((size_t)b * NCHUNK + n) * 1024 + ch] = hf; } } }
    __syncthreads();
    { bf16* hlg = (bf16*)(ws + WS_HL); bf16* ppg = (bf16*)(ws + WS_PP);
#pragma unroll
      for (int k = 0; k < 2; ++k) { const int e = tid + NTHR * k, i = e >> 4, c8 = (e & 15) * 8, t = 64 * n - 48 + i;
          if (t >= 0) { const size_t o = ((size_t)b * TP + t) * 1024 + blk * 128 + c8; *(u32x4*)(hlg + o) = *(const LAS u32x4*)(HLb + i * 128 + c8); *(u32x4*)(ppg + o) = *(const LAS u32x4*)(PPb + i * 128 + c8); } } }
    __syncthreads();
}
__device__ __forceinline__ void lru_carry(const Params& p, int gi) {
    const int b = gi >> 10, ch = gi & 1023; unsigned char* ws = p.ws; float carry = 0.f;
    const float* A = (const float*)(ws + WS_LRUA) + (size_t)b * NCHUNK * 1024 + ch; const float* B = (const float*)(ws + WS_LRUB) + (size_t)b * NCHUNK * 1024 + ch; float* C = (float*)(ws + WS_LRUC) + (size_t)b * NCHUNK * 1024 + ch;
    for (int n0 = 0; n0 < NCHUNK; n0 += 8) { float a[8], bq[8];
#pragma unroll
        for (int k = 0; k < 8; ++k) { const int n = n0 + k < NCHUNK ? n0 + k : NCHUNK - 1; a[k] = A[(size_t)n * 1024]; bq[k] = B[(size_t)n * 1024]; }
#pragma unroll
        for (int k = 0; k < 8; ++k) if (n0 + k < NCHUNK) { C[(size_t)(n0 + k) * 1024] = carry; carry = a[k] * carry + bq[k]; } }
}

__device__ __forceinline__ void mix1_finalize(const Params& p) {
    const int tid = threadIdx.x, lane = tid & 63, wave = __builtin_amdgcn_readfirstlane(tid >> 6);
    unsigned char* ws = p.ws; const bf16* z = (const bf16*)(ws + WS_Z); bf16* a2 = (bf16*)(ws + WS_A2);
    const float* og = (const float*)(ws + WS_O); const bf16* hlg = (const bf16*)(ws + WS_HL); const bf16* ppg = (const bf16*)(ws + WS_PP);
    const f32x4 g0 = *(const f32x4*)(p.in[16] + 8 * (lane & 15)), g1 = *(const f32x4*)(p.in[16] + 8 * (lane & 15) + 4);
    const int gw = blockIdx.x * NWAVES + wave, NGW = gridDim.x * NWAVES;
    for (int tok = gw; tok < NTOK; tok += NGW) {
        const int b = tok / T, t = tok - b * T; const size_t row = (size_t)b * TP + t; const int n = (t + 48) >> 6;
        const float* car = (const float*)(ws + WS_LRUC) + ((size_t)b * NCHUNK + n) * 1024;
#pragma unroll
        for (int jj = 0; jj < 2; ++jj) { const int c0 = 512 * jj + 8 * lane;
            const f32x4 o0 = *(const f32x4*)(og + row * 1024 + c0), o1 = *(const f32x4*)(og + row * 1024 + c0 + 4); const u32x4 zc = *(const u32x4*)(z + row * LDZ1 + 3072 + c0);
            const float ss = row16_sum((o0[0] * o0[0] + o0[1] * o0[1]) + (o0[2] * o0[2] + o0[3] * o0[3]) + (o1[0] * o1[0] + o1[1] * o1[1]) + (o1[2] * o1[2] + o1[3] * o1[3]));
            const float rstd = rsqrtf(ss * (1.0f / 128.0f) + EPS);
            u32x4 w; w.x = pk2(o0[0] * rstd * g0[0] * siluf_(bflo(zc.x)), o0[1] * rstd * g0[1] * siluf_(bfhi(zc.x))); w.y = pk2(o0[2] * rstd * g0[2] * siluf_(bflo(zc.y)), o0[3] * rstd * g0[3] * siluf_(bfhi(zc.y)));
            w.z = pk2(o1[0] * rstd * g1[0] * siluf_(bflo(zc.z)), o1[1] * rstd * g1[1] * siluf_(bfhi(zc.z))); w.w = pk2(o1[2] * rstd * g1[2] * siluf_(bflo(zc.w)), o1[3] * rstd * g1[3] * siluf_(bfhi(zc.w)));
            *(u32x4*)(a2 + row * DM + c0) = w;
            const u32x4 hl = *(const u32x4*)(hlg + row * 1024 + c0), pp = *(const u32x4*)(ppg + row * 1024 + c0), gd = *(const u32x4*)(z + row * LDZ1 + 5120 + c0);
            const f32x4 c0v = *(const f32x4*)(car + c0), c1v = *(const f32x4*)(car + c0 + 4);
            u32x4 y; y.x = pk2((bflo(hl.x) + bflo(pp.x) * c0v[0]) * geluf_tanh(bflo(gd.x)), (bfhi(hl.x) + bfhi(pp.x) * c0v[1]) * geluf_tanh(bfhi(gd.x)));
            y.y = pk2((bflo(hl.y) + bflo(pp.y) * c0v[2]) * geluf_tanh(bflo(gd.y)), (bfhi(hl.y) + bfhi(pp.y) * c0v[3]) * geluf_tanh(bfhi(gd.y)));
            y.z = pk2((bflo(hl.z) + bflo(pp.z) * c1v[0]) * geluf_tanh(bflo(gd.z)), (bfhi(hl.z) + bfhi(pp.z) * c1v[1]) * geluf_tanh(bfhi(gd.z)));
            y.w = pk2((bflo(hl.w) + bflo(pp.w) * c1v[2]) * geluf_tanh(bflo(gd.w)), (bfhi(hl.w) + bfhi(pp.w) * c1v[3]) * geluf_tanh(bfhi(gd.w)));
            *(u32x4*)(a2 + row * DM + 1024 + c0) = y; }
    }
}

typedef short tbf16x8 __attribute__((ext_vector_type(8)));
template <int KIND> __device__ __forceinline__ void tail_gemm(const Params& p, const bf16* A, const bf16* Bt) {
    const int tid = threadIdx.x, lane = tid & 63, wave = __builtin_amdgcn_readfirstlane(tid >> 6), r = lane & 15, q = lane >> 4;
    const int gw = wave * gridDim.x + blockIdx.x, NGW = gridDim.x * NWAVES;
    unsigned char* ws = p.ws;
    constexpr int NPLAIN = KIND == 0 ? 3072 / 16 : KIND == 1 ? 6144 / 16 : 2048 / 16, NGLU = KIND == 0 ? 64 : 0;
    for (int tix = gw; tix < 2 * NPLAIN; tix += NGW) {
        const int rb = tix & 1, ct = tix >> 1, colA = ct * 16; const size_t row0 = (size_t)rb * TP + 8192;
        const bf16* ap = A + (row0 + r) * DM + 8 * q; const bf16* bp = Bt + (size_t)(colA + r) * DM + 8 * q;
        f32x4 acc = (f32x4){0.f, 0.f, 0.f, 0.f};
#pragma unroll 1
        for (int s0 = 0; s0 < 64; s0 += 16) { tbf16x8 af[16], bf[16];
#pragma unroll
            for (int s = 0; s < 16; ++s) { af[s] = *(const tbf16x8*)(ap + 32 * (s0 + s)); bf[s] = *(const tbf16x8*)(bp + 32 * (s0 + s)); }
#pragma unroll
            for (int s = 0; s < 16; ++s) acc = __builtin_amdgcn_mfma_f32_16x16x32_bf16(af[s], bf[s], acc, 0, 0, 0); }
#pragma unroll
        for (int e = 0; e < 4; ++e) { const size_t row = row0 + 4 * q + e;
            if (KIND == 2) { bf16* hp = (bf16*)(ws + WS_H) + row * DM + colA + r; *hp = (bf16)f2bf(bf2f(*hp) + acc[e]); }
            else if (KIND == 1) ((bf16*)(ws + WS_Z))[row * LDZ1 + colA + r] = (bf16)f2bf(acc[e]);
            else ((bf16*)(ws + WS_Z))[row * LDZ0 + colA + r] = (bf16)f2bf(acc[e]); }
    }
    if (KIND == 0) for (int tix = gw; tix < 2 * NGLU; tix += NGW) {
        const int rb = tix & 1, g = tix >> 1, pt = g >> 3, cb = g & 7, colA = 3072 + pt * 256 + cb * 16; const size_t row0 = (size_t)rb * TP + 8192;
        const bf16* ap = A + (row0 + r) * DM + 8 * q; const bf16* bp = Bt + (size_t)(colA + r) * DM + 8 * q; const bf16* bp2 = bp + (size_t)128 * DM;
        f32x4 acc = (f32x4){0.f, 0.f, 0.f, 0.f}, acc2 = acc;
#pragma unroll 1
        for (int s0 = 0; s0 < 64; s0 += 8) { tbf16x8 af[8], bf[8], bg[8];
#pragma unroll
            for (int s = 0; s < 8; ++s) { af[s] = *(const tbf16x8*)(ap + 32 * (s0 + s)); bf[s] = *(const tbf16x8*)(bp + 32 * (s0 + s)); bg[s] = *(const tbf16x8*)(bp2 + 32 * (s0 + s)); }
#pragma unroll
            for (int s = 0; s < 8; ++s) { acc = __builtin_amdgcn_mfma_f32_16x16x32_bf16(af[s], bf[s], acc, 0, 0, 0); acc2 = __builtin_amdgcn_mfma_f32_16x16x32_bf16(af[s], bg[s], acc2, 0, 0, 0); } }
#pragma unroll
        for (int e = 0; e < 4; ++e) { const size_t row = row0 + 4 * q + e;
            ((bf16*)(ws + WS_U))[row * 1024 + pt * 128 + cb * 16 + r] = (bf16)f2bf(acc[e] * __builtin_amdgcn_rcpf(1.0f + __expf(-acc2[e]))); }
    }
}

enum { PH_PRO = 0, PH_IN0, PH_CONV0, PH_MIX0, PH_OUT0, PH_FA0, PH_FB0, PH_FC0, PH_FD0, PH_NORM1, PH_IN1, PH_MIX1A, PH_MIX1B, PH_CARRY, PH_MIX1C, PH_OUT1, PH_FA1, PH_FB1, PH_FC1, PH_FD1, PH_FINAL, NPH };

#define XB_TMO      128
#define XB_XCNT(j)  (256  + 64 * (j))
#define XB_XSUB(j)  (1280 + 64 * (j))
#define XB_XGEN(j)  (2304 + 64 * (j))
#define XB_TOP      3328
#define XB_TOPGEN   3392
#define XCD_BAR_WORDS 3456
#define XB_SPIN_CAP (1u << 18)

__device__ __forceinline__ unsigned xb_ld(unsigned* p)              { return __hip_atomic_load(p, __ATOMIC_RELAXED, __HIP_MEMORY_SCOPE_AGENT); }
__device__ __forceinline__ unsigned xb_add(unsigned* p, unsigned v) { return __hip_atomic_fetch_add(p, v, __ATOMIC_RELAXED, __HIP_MEMORY_SCOPE_AGENT); }
__device__ __forceinline__ unsigned xb_xcc_id() { return (unsigned)__builtin_amdgcn_s_getreg((3 << 11) | 20) & 0xFu; }
#define XB_SPIN(cond, bar) do { unsigned _sp = 0; while (cond) { \
    if ((++_sp & 255u) == 0u) { if (xb_ld(&(bar)[XB_TMO])) break; if (_sp > XB_SPIN_CAP) { atomicAdd(&(bar)[XB_TMO], 1u); break; } } } } while (0)

struct XcdBarrier {
    unsigned* bar; unsigned x;
    volatile LAS unsigned* st;
};

__device__ __forceinline__ XcdBarrier xcd_barrier_post(unsigned* bar, volatile LAS unsigned* st) {
    XcdBarrier b; b.bar = bar; b.x = xb_xcc_id(); b.st = st;
    if (threadIdx.x == 0) (void)xb_add(&bar[XB_XCNT(b.x)], 1u);
    return b;
}
__device__ __forceinline__ void xcd_barrier_complete(unsigned* bar, unsigned x, unsigned& nloc, unsigned& nx) {
    const unsigned G = gridDim.x * gridDim.y * gridDim.z;
    unsigned sum, cnt, mine, sp = 0u;
    for (;;) {
        sum = 0u; cnt = 0u; mine = 0u;
#pragma unroll
        for (unsigned j = 0; j < 16; ++j) { const unsigned c = xb_ld(&bar[XB_XCNT(j)]); sum += c; cnt += (c > 0u) ? 1u : 0u; mine = (j == x) ? c : mine; }
        if (sum == G) break;
        __builtin_amdgcn_s_sleep(1);
        if ((++sp & 255u) == 0u) { if (xb_ld(&bar[XB_TMO])) break; if (sp > XB_SPIN_CAP) { atomicAdd(&bar[XB_TMO], 1u); break; } }
    }
    nloc = mine > 0u ? mine : 1u; nx = cnt > 0u ? cnt : 1u;
}

__device__ __forceinline__ void xcd_barrier(const XcdBarrier& b) {
    asm volatile("s_waitcnt vmcnt(0)" ::: "memory");
    __syncthreads();
    if (threadIdx.x == 0) {
        unsigned* bar = b.bar;
        __builtin_amdgcn_s_waitcnt(0);
        unsigned nloc = b.st[0], nx = b.st[1];
        if (nloc == 0u) { xcd_barrier_complete(bar, b.x, nloc, nx); b.st[0] = nloc; b.st[1] = nx; }
        const unsigned old = xb_add(&bar[XB_XSUB(b.x)], 1u);
        const unsigned gen = old / nloc;
        if (old + 1u == (gen + 1u) * nloc) {
            __builtin_amdgcn_fence(__ATOMIC_RELEASE, "agent");
            asm volatile("s_waitcnt vmcnt(0)" ::: "memory");
            const unsigned og = xb_add(&bar[XB_TOP], 1u);
            const unsigned tg = og / nx;
            if (og + 1u == (tg + 1u) * nx) xb_add(&bar[XB_TOPGEN], 1u);
            else XB_SPIN(xb_ld(&bar[XB_TOPGEN]) == tg, bar);
            __builtin_amdgcn_fence(__ATOMIC_ACQUIRE, "agent");
            xb_add(&bar[XB_XGEN(b.x)], 1u);
            asm volatile("s_waitcnt vmcnt(0)" ::: "memory");
        } else {
            XB_SPIN(xb_ld(&bar[XB_XGEN(b.x)]) == gen, bar);
            __builtin_amdgcn_fence(__ATOMIC_ACQUIRE, "agent");
            asm volatile("s_waitcnt vmcnt(0)" ::: "memory");
        }
    }
    __syncthreads();
}

template <int PH> __device__ __forceinline__ void run_phase(const Params& p0, LAS unsigned char* lds) {
    const Params& p = p0;
    unsigned char* ws = p.ws;
#define TIDS const int tid = threadIdx.x, lane = tid & 63, wave = __builtin_amdgcn_readfirstlane(tid >> 6); const int gw = blockIdx.x * NWAVES + wave, NGW = gridDim.x * NWAVES, gtid = blockIdx.x * NTHR + tid, GT = gridDim.x * NTHR; (void)lane; (void)gw; (void)NGW; (void)gtid; (void)GT
    if constexpr (PH == PH_PRO) { TIDS;
        if (gtid < 2048) ((unsigned*)(ws + WS_CTL))[gtid] = 0u; if (gtid < 4096) ((unsigned*)(ws + WS_READY))[gtid] = 0u;
        convert_weights(p, lds, 0, N_DENSE_ITEMS, 0);
        conv_extras(p, gtid, GT);
        for (int i = gtid; i < 2 * (TP - T) * (DM / 8); i += GT) { const int r = i / (DM / 8), c = i - r * (DM / 8), b = r / (TP - T), t = T + r - b * (TP - T); const size_t o = ((size_t)b * TP + t) * DM + c * 8;
            *(u32x4*)((bf16*)(ws + WS_HN) + o) = (u32x4){0u, 0u, 0u, 0u}; *(u32x4*)((bf16*)(ws + WS_A2) + o) = (u32x4){0u, 0u, 0u, 0u}; }
        for (int i = gtid; i < 16 * (TP - T); i += GT) { const int bh = i / (TP - T), t = T + i - bh * (TP - T); ((float*)(ws + WS_LOGF))[(size_t)bh * TP + t] = 0.f; }
        for (int i = gtid; i < 2 * (TP - T) * (LDZ0 / 8); i += GT) { const int r = i / (LDZ0 / 8), c = i - r * (LDZ0 / 8), b = r / (TP - T), t = T + r - b * (TP - T);
            *(u32x4*)((bf16*)(ws + WS_Z) + ((size_t)b * TP + t) * LDZ0 + c * 8) = (u32x4){0u, 0u, 0u, 0u}; }
        __syncthreads(); norm_phase<0>(p, lds, 0);
    }
    if constexpr (PH == PH_IN0) {
        for (int bh = blockIdx.x; bh < 16; bh += gridDim.x) fox_cumsum(p, lds, bh);
        pg8::Gemm g{(const bf16*)(ws + WS_HN), (const bf16*)(ws + WS_W0IN), MROWS, 5120, DM}; pg8::Order64Range S; S.init(64 * 256, 5120, gridDim.x, blockIdx.x);
        pg8::EpiIn0 E{(bf16*)(ws + WS_Z), (bf16*)(ws + WS_U)};
        { const int R = (S.nwg + (int)gridDim.x - 1) / (int)gridDim.x, slot = ((int)blockIdx.x >> 3) % R;
#pragma unroll 1
          for (int part = 0; part < 2; ++part) { S.i0 = part ? slot : 0; S.i1 = part ? (1 << 30) : slot;
              pg8::gemm_phase<pg8::EpiIn0, pg8::Order64Range, true, true>(lds, g, S, E);
              if (part == 0) { convert_weights(p, lds, 0, 0, N_MOE_ITEMS); asm volatile("s_waitcnt vmcnt(0) lgkmcnt(0)" ::: "memory"); __syncthreads(); } } }
        tail_gemm<0>(p, (const bf16*)(ws + WS_HN), (const bf16*)(ws + WS_W0IN));
    }
    if constexpr (PH == PH_MIX0) mix0_phase(p, lds);
    if constexpr (PH == PH_CONV0) conv_phase(p, lds);
    if constexpr (PH == PH_OUT0 || PH == PH_OUT1) { pg8::Gemm g{(const bf16*)(ws + WS_A2), (const bf16*)(ws + (PH == PH_OUT0 ? WS_W0OUT : WS_W1OUT)), MROWS, DM, DM}; pg8::Order64 S; S.init(64 * 256, DM, gridDim.x, blockIdx.x);
        pg8::EpiResid E{(bf16*)(ws + WS_H), DM}; pg8::gemm_phase<pg8::EpiResid, pg8::Order64, true, true>(lds, g, S, E);
        tail_gemm<2>(p, (const bf16*)(ws + WS_A2), (const bf16*)(ws + (PH == PH_OUT0 ? WS_W0OUT : WS_W1OUT))); }
    if constexpr (PH == PH_FA0 || PH == PH_FA1) norm_phase<1>(p, lds, PH == PH_FA0 ? 0 : 1);
    if constexpr (PH == PH_FB0 || PH == PH_FB1) moe_scatter_phase(p, lds);
    if constexpr (PH == PH_FC0 || PH == PH_FC1) { LAS int* tab = (LAS int*)(lds + MISC_OFF); moe_offsets((const unsigned*)(ws + WS_CTL), tab);
        pg8::Gemm g{(const bf16*)(ws + WS_HN), (const bf16*)(ws + WS_WGU), RMAX, NEXP * 1024, DM};
        pg8::MoeOrderPub S; S.NB = tab[64]; S.ncol = 4; S.nwg = S.NB * 4; S.G = gridDim.x; S.c = blockIdx.x; S.blk_e = tab + 65; S.ready = (unsigned*)(ws + WS_READY);
        pg8::EpiSwiGLUPub E{(bf16*)(ws + WS_HID), (unsigned)(RMAX * 1024)}; pg8::gemm_phase_gather<pg8::EpiSwiGLUPub, pg8::MoeOrderPub>(lds, g, S, E, (const int*)(ws + WS_ROWTOK)); }
    if constexpr (PH == PH_FD0 || PH == PH_FD1) { LAS int* tab = (LAS int*)(lds + MISC_OFF);
        pg8::Gemm g{(const bf16*)(ws + WS_HID), (const bf16*)(ws + WS_WD), RMAX, NEXP * 2048, DEXP};
        pg8::MoeOrderDyn S; S.NB = tab[64]; S.x = blockIdx.x & 7; S.blk_e = tab + 65; S.tickets = (unsigned*)(ws + WS_READY) + 3072; S.ready = (const unsigned*)(ws + WS_READY); S.tmo = (unsigned*)(ws + WS_READY) + 4000; S.slot = tab + 400;
        pg8::EpiDown E{(bf16*)(ws + WS_XS)}; pg8::gemm_phase_dyn<pg8::EpiDown, pg8::MoeOrderDyn>(lds, g, S, E); }
    if constexpr (PH == PH_NORM1) { TIDS;
        if (gtid < 2048) ((unsigned*)(ws + WS_CTL))[gtid] = 0u; if (gtid < 4096) ((unsigned*)(ws + WS_READY))[gtid] = 0u;
        norm_phase<2>(p, lds, 1);
    }
    if constexpr (PH == PH_IN1) {
        pg8::Gemm g{(const bf16*)(ws + WS_HN), (const bf16*)(ws + WS_W1IN), MROWS, LDZ1, DM}; pg8::Order64Range S; S.init(64 * 256, LDZ1, gridDim.x, blockIdx.x);
        pg8::EpiBf16<0> E{(bf16*)(ws + WS_Z), LDZ1, nullptr, 0, 0, 1.f};
        { const int R = (S.nwg + (int)gridDim.x - 1) / (int)gridDim.x, slot = ((int)blockIdx.x >> 3) % R;
#pragma unroll 1
          for (int part = 0; part < 2; ++part) { S.i0 = part ? slot : 0; S.i1 = part ? (1 << 30) : slot;
              pg8::gemm_phase<pg8::EpiBf16<0>, pg8::Order64Range, true, true>(lds, g, S, E);
              if (part == 0) { convert_weights(p, lds, 1, 0, N_MOE_ITEMS); asm volatile("s_waitcnt vmcnt(0) lgkmcnt(0)" ::: "memory"); __syncthreads(); } } }
        tail_gemm<1>(p, (const bf16*)(ws + WS_HN), (const bf16*)(ws + WS_W1IN));
    }
    if constexpr (PH == PH_MIX1A) {
        { const int wend = (gridDim.x > 68 ? PREP_SPLIT : NCHUNK) * 16; PrepPre P; int w = blockIdx.x; if (w < wend) gdn_prep_issue(p, PREP_ITEM(w), P);
          for (; w < wend; w += gridDim.x) { const int wn = w + gridDim.x; gdn_prep_item(p, lds, PREP_ITEM(w), P, wn < wend ? PREP_ITEM(wn) : NCH); } }
    }
    if constexpr (PH == PH_MIX1B) {
        const int G = gridDim.x, first = G > 68 ? 64 : 0;
        if ((int)blockIdx.x < 64 || first == 0) for (int it = blockIdx.x; it < 64; it += gridDim.x) { if (first) gdn_scan_item<0, true>(p, lds, it); else gdn_scan_item<0, false>(p, lds, it); }
        if ((int)blockIdx.x >= first) {
            if (first) {
                const int nb = G - first, wend = NCHUNK * 16; PrepPre P; int w = PREP_SPLIT * 16 + (int)blockIdx.x - first; if (w < wend) gdn_prep_issue(p, PREP_ITEM(w), P);
                for (; w < wend; w += nb) { const int wn = w + nb; gdn_prep_item(p, lds, PREP_ITEM(w), P, wn < wend ? PREP_ITEM(wn) : NCH); }
                asm volatile("s_waitcnt vmcnt(0)" ::: "memory"); __syncthreads();
                if (threadIdx.x == 0) { __builtin_amdgcn_fence(__ATOMIC_RELEASE, "agent"); asm volatile("s_waitcnt vmcnt(0)" ::: "memory");
                    __hip_atomic_fetch_add((unsigned*)(ws + WS_FLAG), 1u, __ATOMIC_RELAXED, __HIP_MEMORY_SCOPE_AGENT); }
                __syncthreads();
            }
            for (int it = (int)blockIdx.x - first; it < 2 * NCHUNK * 8; it += G - first) lru_item(p, lds, it);
        }
    }
    if constexpr (PH == PH_CARRY) { const int tid = threadIdx.x; for (int gi = blockIdx.x * NTHR + tid; gi < 2048; gi += gridDim.x * NTHR) lru_carry(p, gi); }
    if constexpr (PH == PH_MIX1C) mix1_finalize(p);
    if constexpr (PH == NPH + 1) { PrepPre P; int it = blockIdx.x; if (it < NCH) gdn_prep_issue(p, it, P);
          for (; it < NCH; it += gridDim.x) gdn_prep_item(p, lds, it, P, it + gridDim.x); }
    if constexpr (PH == NPH + 13 || PH == NPH + 14 || PH == NPH + 15 || PH == NPH + 16 || PH == NPH + 17 || PH == NPH + 18 || PH == NPH + 19) { constexpr int AB = PH == NPH + 13 ? 1 : PH == NPH + 14 ? 2 : PH == NPH + 15 ? 4 : PH == NPH + 17 ? 8 : PH == NPH + 18 ? 16 : PH == NPH + 19 ? 32 : 7; PrepPre P; int it = blockIdx.x; if (it < NCH) gdn_prep_issue(p, it, P);
          for (; it < NCH; it += gridDim.x) gdn_prep_item<AB>(p, lds, it, P, it + gridDim.x); }
    if constexpr (PH == NPH + 2) for (int it = blockIdx.x; it < 2 * NCHUNK * 8; it += gridDim.x) lru_item(p, lds, it);
    if constexpr (PH == NPH + 3) for (int it = blockIdx.x; it < 64; it += gridDim.x) gdn_scan_item(p, lds, it);
    if constexpr (PH == NPH + 5) for (int it = blockIdx.x; it < 64; it += gridDim.x) gdn_scan_item<1>(p, lds, it);
    if constexpr (PH == NPH + 6) for (int it = blockIdx.x; it < 64; it += gridDim.x) gdn_scan_item<3>(p, lds, it);
    if constexpr (PH == NPH + 7) for (int it = blockIdx.x; it < 64; it += gridDim.x) gdn_scan_item<7>(p, lds, it);
    if constexpr (PH == NPH + 4) convert_weights(p, lds, 1, 0, N_MOE_ITEMS);
    if constexpr (PH == NPH + 20 || PH == NPH + 21 || PH == NPH + 22) {
        pg8::Gemm g{(const bf16*)(ws + WS_HN), (const bf16*)(ws + WS_W1IN), MROWS, LDZ1, DM}; pg8::Order64 S; S.init(64 * 256, LDZ1, gridDim.x, blockIdx.x);
        pg8::EpiBf16<0> E{(bf16*)(ws + WS_Z), LDZ1, nullptr, 0, 0, 1.f};
        if constexpr (PH == NPH + 20) pg8::gemm_phase<pg8::EpiBf16<0>, pg8::Order64, true, true>(lds, g, S, E);
        if constexpr (PH == NPH + 21) pg8::gemm_phase<pg8::EpiBf16<0>, pg8::Order64, true, false>(lds, g, S, E);
        if constexpr (PH == NPH + 22) pg8::gemm_phase<pg8::EpiBf16<0>, pg8::Order64, false, true>(lds, g, S, E); }
    if constexpr (PH == NPH + 11) convert_weights(p, lds, 0, N_DENSE_ITEMS, 0);
    if constexpr (PH == NPH + 12) norm_phase<0>(p, lds, 0);
    if constexpr (PH == NPH + 8) norm_phase<3, 1>(p, lds, 0);
    if constexpr (PH == NPH + 9) norm_phase<3, 2>(p, lds, 0);
    if constexpr (PH == NPH + 10) norm_phase<3, 3>(p, lds, 0);
    if constexpr (PH == PH_FINAL) norm_phase<3>(p, lds, 0);
#undef TIDS
}

__global__ void __launch_bounds__(NTHR, 2) mk_fwd(Params p) {
    extern __shared__ __attribute__((aligned(16))) unsigned char lds_raw[];
    LAS unsigned char* lds = (LAS unsigned char*)lds_raw;
    cg::grid_group grid = cg::this_grid();
    const int lo = p.ph_lo, hi = p.ph_hi;
    volatile LAS unsigned* bst = (volatile LAS unsigned*)(lds + LDS_BYTES - 16);
    if (threadIdx.x < 2) bst[threadIdx.x] = 0u;
    __syncthreads();
    (void)xcd_barrier_post((unsigned*)(p.ws + WS_BAR), bst);
    if (hi < -12345) grid.sync();
#define XBAR() do { XcdBarrier b_; b_.bar = (unsigned*)(p.ws + WS_BAR); b_.x = xb_xcc_id(); b_.st = (volatile LAS unsigned*)(lds + LDS_BYTES - 16); xcd_barrier(b_); } while (0)
#define PHASE(k) do { if (lo <= (k) && (k) < hi) { run_phase<(k)>(p, lds); if ((k) + 1 < hi) XBAR(); } } while (0)
#define PHASE_NB(k) do { if (lo <= (k) && (k) < hi) { run_phase<(k)>(p, lds); asm volatile("s_waitcnt vmcnt(0) lgkmcnt(0)" ::: "memory"); __syncthreads(); } } while (0)
    PHASE(PH_PRO); PHASE(PH_IN0); PHASE_NB(PH_CONV0); PHASE(PH_MIX0); PHASE(PH_OUT0); PHASE(PH_FA0); PHASE(PH_FB0); PHASE_NB(PH_FC0); PHASE(PH_FD0); PHASE(PH_NORM1);
    PHASE(PH_IN1); PHASE(PH_MIX1A); PHASE(PH_MIX1B); PHASE(PH_CARRY); PHASE(PH_MIX1C); PHASE(PH_OUT1); PHASE(PH_FA1); PHASE(PH_FB1); PHASE_NB(PH_FC1); PHASE(PH_FD1); PHASE(PH_FINAL);
#if MK_EXTRA_PHASE >= 0
#pragma unroll 1
    for (int xr = 0; xr < MK_EXTRA_REPS; ++xr) { XBAR(); run_phase<MK_EXTRA_PHASE>(p, lds); }
#endif
#undef PHASE
}

extern "C" void kernel_launch(void* const* d_in, const int* in_sizes, int n_in, void* d_out, int out_size, void* d_ws, size_t ws_size, hipStream_t stream) {
    static int grid = 0;
    if (grid == 0) {
        if (n_in != 32 || ws_size < WS_END) { fprintf(stderr, "kernel_launch: expected 32 inputs and >= %zu bytes of workspace (got %d, %zu)\n", (size_t)WS_END, n_in, ws_size); grid = -1; return; }
        int dev = 0, cus = 0, per_cu = 0;
        hipGetDevice(&dev); hipDeviceGetAttribute(&cus, hipDeviceAttributeMultiprocessorCount, dev);
        if (hipFuncSetAttribute((const void*)mk_fwd, hipFuncAttributeMaxDynamicSharedMemorySize, LDS_BYTES) != hipSuccess) { fprintf(stderr, "kernel_launch: hipFuncSetAttribute failed\n"); grid = -1; return; }
        if (hipOccupancyMaxActiveBlocksPerMultiprocessor(&per_cu, (const void*)mk_fwd, NTHR, LDS_BYTES) != hipSuccess || per_cu < 1) { fprintf(stderr, "kernel_launch: occupancy query failed (%d)\n", per_cu); per_cu = 1; }
        (void)hipGetLastError();
        grid = cus * (per_cu > 1 ? 1 : per_cu);
        if (grid <= 0) grid = 256;
    }
    if (grid < 0) return;
    (void)hipMemsetAsync((char*)d_ws + WS_BAR, 0, 16 * 1024 + 256, stream);
    Params p{};
    for (int i = 0; i < 32; ++i) p.in[i] = (const float*)d_in[i];
    p.out = (float*)d_out; p.ws = (unsigned char*)d_ws;
#if MK_ONE_LAUNCH
    p.ph_lo = 0; p.ph_hi = NPH;
    void* args[] = {&p};
    hipError_t e = hipLaunchCooperativeKernel((const void*)mk_fwd, dim3(grid), dim3(NTHR), args, LDS_BYTES, stream);
    if (e != hipSuccess) fprintf(stderr, "cooperative launch failed: %s (grid %d)\n", hipGetErrorString(e), grid);
#else
    for (int ph = 0; ph < NPH && ph < MK_LAST_PHASE; ++ph) { p.ph_lo = ph; p.ph_hi = ph + 1; hipLaunchKernelGGL(mk_fwd, dim3(grid), dim3(NTHR), LDS_BYTES, stream, p); }
#endif
}
```
